# Optimizing an MI355X kernel written in HIP

```python
import math
import jax, jax.numpy as jnp
from jax import lax
import numpy as np

D_MODEL = 1024
BATCH = 32
SEQ = 256
DEPTH = 4
DEC_BATCH = 4
DEC_SEQ = 1024
PAST_LEN = 256

GRID_W = 64
HEAD_DIM = 64
N_Q_HEADS = 8
N_KV_HEADS = 2
Q_PER_KV = N_Q_HEADS // N_KV_HEADS
ATTN_W = N_Q_HEADS * HEAD_DIM
KV_W = N_KV_HEADS * HEAD_DIM
POOL_WINDOWS = (2, 4, 8, 16)
N_POOL_GROUPS = len(POOL_WINDOWS)
POOL_W = D_MODEL // 2
POOL_GW = POOL_W // N_POOL_GROUPS
N_BRANCHES = 2
IN_COLS = ATTN_W + 2 * KV_W + POOL_W + N_BRANCHES * D_MODEL
FFN_HIDDEN = ((8 * D_MODEL + 3 * 256 - 1) // (3 * 256)) * 256
N_MOD = 6
Q_BLOCK = 128
ROPE_THETA = 10000.0
EPS = 1e-6

kernel_name = 'hybrid_gqa_pool_prefix_dit_step'


def rmsnorm(x, g):
    xf = x.astype(jnp.float32)
    y = xf * lax.rsqrt(jnp.mean(xf * xf, axis=-1, keepdims=True) + EPS)
    return (y * g.astype(jnp.float32)).astype(x.dtype)


def grid_rope(n):
    rows = n // GRID_W
    row = jnp.broadcast_to(jnp.arange(rows, dtype=jnp.int32)[:, None], (rows, GRID_W)).reshape(-1)
    col = jnp.broadcast_to(jnp.arange(GRID_W, dtype=jnp.int32)[None, :], (rows, GRID_W)).reshape(-1)
    n_freq = HEAD_DIM // 4
    inv = ROPE_THETA ** (-jnp.arange(n_freq, dtype=jnp.float32) / n_freq)
    ang = jnp.concatenate([row.astype(jnp.float32)[:, None] * inv[None, :],
                           col.astype(jnp.float32)[:, None] * inv[None, :]], axis=-1)
    return jnp.cos(ang), jnp.sin(ang)


def apply_rope(x, cos, sin):
    xf = x.astype(jnp.float32)
    x1, x2 = jnp.split(xf, 2, axis=-1)
    c = cos[None, :, None, :]
    s = sin[None, :, None, :]
    return jnp.concatenate([x1 * c - x2 * s, x2 * c + x1 * s], axis=-1).astype(x.dtype)


def block_attention(q, k, v):
    b, n = q.shape[0], q.shape[1]
    blk = math.gcd(n, Q_BLOCK)
    nb = n // blk
    qb = q.reshape(b, nb, blk, N_KV_HEADS, Q_PER_KV, HEAD_DIM).transpose(1, 0, 2, 3, 4, 5)
    scale = HEAD_DIM ** -0.5

    def one_block(qi):
        s = jnp.einsum('bqhgd,bkhd->bhgqk', qi, k).astype(jnp.float32) * scale
        p = jax.nn.softmax(s, axis=-1).astype(v.dtype)
        return jnp.einsum('bhgqk,bkhd->bqhgd', p, v)

    o = lax.map(one_block, qb)
    return o.transpose(1, 0, 2, 3, 4, 5).reshape(b, n, ATTN_W)


def multiscale_pool(p, w_pool, pool_scale):
    b, n, _ = p.shape
    pf = p.astype(jnp.float32)
    csum = jnp.concatenate([jnp.zeros((b, 1, POOL_W), jnp.float32), jnp.cumsum(pf, axis=1)], axis=1)
    t = jnp.arange(n, dtype=jnp.int32)
    outs = []
    for g, w in enumerate(POOL_WINDOWS):
        left = w // 2
        right = w - 1 - left
        lo = jnp.clip(t - left, 0, n)
        hi = jnp.clip(t + right + 1, 0, n)
        sl = slice(g * POOL_GW, (g + 1) * POOL_GW)
        cs = csum[:, :, sl]
        mean = (cs[:, hi] - cs[:, lo]) / (hi - lo).astype(jnp.float32)[None, :, None]
        d = mean - pf[:, :, sl]
        outs.append(jnp.einsum('bnc,cd->bnd', d, w_pool[g].astype(jnp.float32)))
    y = jnp.concatenate(outs, axis=-1) * pool_scale.astype(jnp.float32)
    return y.astype(p.dtype)


def trunk_layer(x, mod, rope, ctx_k, ctx_v, w_in, q_norm, k_norm, w_attn_up, w_pool, pool_scale,
                w_pool_up, w_out, n_pre_mix, n_post_mix, n_pre_ffn, n_post_ffn,
                w_ffn_gate, w_ffn_up, w_ffn_down):
    b, n, _ = x.shape
    sh1, sc1, g1, sh2, sc2, g2 = jnp.split(mod[:, None, :], N_MOD, axis=-1)
    h = rmsnorm(x, n_pre_mix) * (1 + sc1) + sh1
    proj = h @ w_in
    q, k, v, p, gates = jnp.split(
        proj, [ATTN_W, ATTN_W + KV_W, ATTN_W + 2 * KV_W, ATTN_W + 2 * KV_W + POOL_W], axis=-1)
    q = rmsnorm(q.reshape(b, n, N_Q_HEADS, HEAD_DIM), q_norm)
    k = rmsnorm(k.reshape(b, n, N_KV_HEADS, HEAD_DIM), k_norm)
    v = v.reshape(b, n, N_KV_HEADS, HEAD_DIM)
    if rope is None:
        keys, vals = k, v
    else:
        cos, sin = rope
        q = apply_rope(q, cos, sin)
        k_lat = apply_rope(k, cos, sin)
        keys = jnp.concatenate([ctx_k, k_lat], axis=1)
        vals = jnp.concatenate([ctx_v, v], axis=1)
    attn = block_attention(q, keys, vals) @ w_attn_up
    pool = multiscale_pool(p, w_pool, pool_scale) @ w_pool_up
    g_attn, g_pool = jnp.split(jax.nn.sigmoid(gates), N_BRANCHES, axis=-1)
    mixed = (g_attn * attn + g_pool * pool) @ w_out
    x = x + g1 * rmsnorm(mixed, n_post_mix)
    h2 = rmsnorm(x, n_pre_ffn) * (1 + sc2) + sh2
    f = (jax.nn.silu(h2 @ w_ffn_gate) * (h2 @ w_ffn_up)) @ w_ffn_down
    x = x + g2 * rmsnorm(f, n_post_ffn)
    return x, k, v


def setup_inputs(seed: int = 0) -> dict:
    key = jax.random.key(seed)
    ks = jax.random.split(key, 32)
    nrm = jax.random.normal
    f32 = jnp.float32

    def gain(k, shape):
        return jnp.ones(shape, f32) + 0.05 * nrm(k, shape, f32)

    return {
        'x_prompt': nrm(ks[0], (BATCH, SEQ, D_MODEL), f32),
        'x_sample': nrm(ks[1], (DEC_BATCH, DEC_SEQ, D_MODEL), f32),
        'cache_k': nrm(ks[2], (DEC_BATCH, DEPTH, PAST_LEN, N_KV_HEADS, HEAD_DIM), f32),
        'cache_v': nrm(ks[3], (DEC_BATCH, DEPTH, PAST_LEN, N_KV_HEADS, HEAD_DIM), f32),
        'c': nrm(ks[4], (DEC_BATCH, D_MODEL), f32),
        'c_ctx': nrm(ks[5], (D_MODEL,), f32),
        'w_ada': nrm(ks[6], (DEPTH, D_MODEL, N_MOD * D_MODEL), f32) * (0.5 * D_MODEL ** -0.5),
        'b_ada': 0.01 * nrm(ks[7], (DEPTH, N_MOD * D_MODEL), f32),
        'w_in': nrm(ks[8], (DEPTH, D_MODEL, IN_COLS), f32) * D_MODEL ** -0.5,
        'q_norm': gain(ks[9], (DEPTH, HEAD_DIM)),
        'k_norm': gain(ks[10], (DEPTH, HEAD_DIM)),
        'w_attn_up': nrm(ks[11], (DEPTH, ATTN_W, D_MODEL), f32) * ATTN_W ** -0.5,
        'w_pool': nrm(ks[12], (DEPTH, N_POOL_GROUPS, POOL_GW, POOL_GW), f32) * POOL_GW ** -0.5,
        'pool_scale': gain(ks[13], (DEPTH, POOL_W)),
        'w_pool_up': nrm(ks[14], (DEPTH, POOL_W, D_MODEL), f32) * POOL_W ** -0.5,
        'w_out': nrm(ks[15], (DEPTH, D_MODEL, D_MODEL), f32) * D_MODEL ** -0.5,
        'n_pre_mix': gain(ks[16], (DEPTH, D_MODEL)),
        'n_post_mix': gain(ks[17], (DEPTH, D_MODEL)),
        'n_pre_ffn': gain(ks[18], (DEPTH, D_MODEL)),
        'n_post_ffn': gain(ks[19], (DEPTH, D_MODEL)),
        'w_ffn_gate': nrm(ks[20], (DEPTH, D_MODEL, FFN_HIDDEN), f32) * D_MODEL ** -0.5,
        'w_ffn_up': nrm(ks[21], (DEPTH, D_MODEL, FFN_HIDDEN), f32) * D_MODEL ** -0.5,
        'w_ffn_down': nrm(ks[22], (DEPTH, FFN_HIDDEN, D_MODEL), f32) * FFN_HIDDEN ** -0.5,
    }


def reference(x_prompt, x_sample, cache_k, cache_v, c, c_ctx, w_ada, b_ada, w_in, q_norm, k_norm,
              w_attn_up, w_pool, pool_scale, w_pool_up, w_out, n_pre_mix, n_post_mix, n_pre_ffn,
              n_post_ffn, w_ffn_gate, w_ffn_up, w_ffn_down):
    rope = grid_rope(x_sample.shape[1])
    silu_ctx = jax.nn.silu(c_ctx)[None, :]
    silu_c = jax.nn.silu(c)
    y = x_prompt
    z = x_sample
    new_ks = []
    new_vs = []
    for l in range(DEPTH):
        lw = (w_in[l], q_norm[l], k_norm[l], w_attn_up[l], w_pool[l], pool_scale[l], w_pool_up[l],
              w_out[l], n_pre_mix[l], n_post_mix[l], n_pre_ffn[l], n_post_ffn[l],
              w_ffn_gate[l], w_ffn_up[l], w_ffn_down[l])
        mod_ctx = silu_ctx @ w_ada[l] + b_ada[l]
        mod_lat = silu_c @ w_ada[l] + b_ada[l]
        y, k_ctx, v_ctx = trunk_layer(y, mod_ctx, None, None, None, *lw)
        new_ks.append(k_ctx)
        new_vs.append(v_ctx)
        z, _, _ = trunk_layer(z, mod_lat, rope, cache_k[:, l], cache_v[:, l], *lw)
    new_k = jnp.stack(new_ks, axis=1)
    new_v = jnp.stack(new_vs, axis=1)
    return (y, z, new_k, new_v)
```

```cpp
#include <hip/hip_runtime.h>
#include <cstdio>
#include <cstdint>
namespace pg8 {
#define PG8_LAS __attribute__((address_space(3)))
typedef unsigned short bf16_t;
typedef short bf16x8 __attribute__((ext_vector_type(8)));
typedef float f32x4 __attribute__((ext_vector_type(4)));
typedef unsigned u32x4 __attribute__((ext_vector_type(4)));
constexpr int BM = 256, BK = 64, HALF = 128, HTB = HALF * BK * 2  , STAGE_BYTES = 8 * HTB, NXCD = 8, WGM = 8;

__host__ __device__ __forceinline__ int lds_byte(int r, int c) { const int st = (r >> 4) * 2 + (c >> 5), rr = r & 15, cc = c & 31, ob = rr * 64 + cc * 2; return st * 1024 + (ob ^ (((ob >> 9) & 1) << 5)); }
__host__ __device__ __forceinline__ void stage_rc(int b, int& R, int& C) { const int st = b / 1024, sb = b % 1024, swz = sb ^ (((sb >> 9) & 1) << 5); R = (st >> 1) * 16 + swz / 64; C = (st & 1) * 32 + (swz % 64) / 2; }
__host__ __device__ __forceinline__ int perm32(int rho) { const int n = rho >> 4, i = rho & 15; return 8 * (i >> 2) + 4 * n + (i & 3); }

struct Unit { int pm, pn; };
struct Gemm { const bf16_t* A; const bf16_t* Bt; int M, N, K; };

struct StaticOrder {
    int nM, nN, nwg, G, c;
    __host__ __device__ void init(int M, int N, int G_, int c_) { nM = M / BM; nN = N / BM; nwg = nM * nN; G = G_; c = c_; }
    __host__ __device__ bool next(int i, Unit& u) const {
        const long L = (long)i * G + c; if (L >= nwg) return false;
        int wgid = (int)L; { const int q = nwg / NXCD, r = nwg % NXCD, xcd = wgid % NXCD, off = wgid / NXCD; wgid = (xcd < r ? xcd * (q + 1) : r * (q + 1) + (xcd - r) * q) + off; }
        const int nig = WGM * nN, gid = wgid / nig, fm = gid * WGM, gsz = (nM - fm) < WGM ? (nM - fm) : WGM;
        u.pm = fm + ((wgid % nig) % gsz); u.pn = (wgid % nig) / gsz; return true;
    }
    __device__ __forceinline__ void a_ready(const Unit&) const {}
    __device__ __forceinline__ void done(const Unit&) const {}
};
__device__ __forceinline__ unsigned cvt_pk_bf16(float lo, float hi) { unsigned r; asm volatile("v_cvt_pk_bf16_f32 %0, %1, %2" : "=v"(r) : "v"(lo), "v"(hi)); return r; }
typedef float f32x2 __attribute__((ext_vector_type(2)));
template <class Epi, class Sched, bool ALIGN_EPI = false, bool SP2 = false>
__device__ __forceinline__ void gemm_phase(PG8_LAS unsigned char* lds, const Gemm g, const Sched& S, const Epi& E) {
    int tid_ = threadIdx.x; asm volatile("" : "+v"(tid_));
    const int tid = tid_, wid = __builtin_amdgcn_readfirstlane(tid >> 6), lane = tid & 63, wr = wid >> 2, wc = wid & 3, fr = lane & 15, fq = lane >> 4;
    const int K = g.K, nt = K / BK;
    unsigned voffA[2], voffB[2];
#pragma unroll
    for (int i = 0; i < 2; ++i) { int R, C; stage_rc(tid * 16 + i * 8192, R, C); const int Rin = Epi::PERM ? perm32(R & 31) : (R & 31); const int Rb = Epi::NMAP64 ? (64 * (R >> 5) + Rin) : ((R & ~31) + Rin);
        voffA[i] = (unsigned)(R * K + C) * 2u; voffB[i] = (unsigned)(Rb * K + C) * 2u; }
    const size_t kstep = (size_t)(BK * 2);
    const size_t hstep = (size_t)HALF * K * 2;
    const size_t hstepB = Epi::NMAP64 ? (size_t)32 * K * 2 : hstep;
    const size_t tstep = 2 * hstep;
    const unsigned ldsw = (unsigned)wid * 1024u;
    const int aoff = lds_byte(wr * 64 + fr, fq * 8), boff = lds_byte(wc * 32 + fr, fq * 8);
#define PG8_SA(b, h) (((b) * 2 + (h)) * HTB)
#define PG8_SB(b, h) ((4 + (b) * 2 + (h)) * HTB)
#define PG8_STAGE(bufoff, gbase, voff) do { _Pragma("unroll") for (int _i = 0; _i < 2; ++_i) \
        __builtin_amdgcn_global_load_lds((const unsigned*)((const char*)(gbase) + (voff)[_i]), (PG8_LAS unsigned*)(lds + (bufoff) + ldsw + _i * 8192), 16, 0, 0); } while (0)
#define PG8_LDA(dst, b, h) do { _Pragma("unroll") for (int m = 0; m < 4; ++m) _Pragma("unroll") for (int k = 0; k < 2; ++k) dst[m][k] = *(const PG8_LAS bf16x8*)(lds + PG8_SA(b, h) + aoff + m * 2048 + k * 1024); } while (0)
#define PG8_LDB(dst, b, h) do { _Pragma("unroll") for (int n = 0; n < 2; ++n) _Pragma("unroll") for (int k = 0; k < 2; ++k) dst[n][k] = *(const PG8_LAS bf16x8*)(lds + PG8_SB(b, h) + boff + n * 2048 + k * 1024); } while (0)
#define PG8_MMA(ai, bj, At, Bt) do { __builtin_amdgcn_s_setprio(1); _Pragma("unroll") for (int m = 0; m < 4; ++m) _Pragma("unroll") for (int n = 0; n < 2; ++n) _Pragma("unroll") for (int k = 0; k < 2; ++k) \
        acc[ai][bj][m][n] = __builtin_amdgcn_mfma_f32_16x16x32_bf16(Bt[n][k], At[m][k], acc[ai][bj][m][n], 0, 0, 0); __builtin_amdgcn_s_setprio(0); } while (0)
#define PG8_WAIT_V(n) asm volatile("s_waitcnt vmcnt(" #n ")" ::: "memory")
#define PG8_WAIT_L(n) asm volatile("s_waitcnt lgkmcnt(" #n ")" ::: "memory")
#define PG8_BAR __builtin_amdgcn_s_barrier()
#define PG8_SCHED __builtin_amdgcn_sched_barrier(0)
    Unit cur, nxt; int ui = 0;
    if (!S.next(0, cur)) return;
    f32x4 acc[2][2][4][2];
#pragma unroll
    for (int a = 0; a < 2; ++a)
#pragma unroll
        for (int b = 0; b < 2; ++b)
#pragma unroll
            for (int m = 0; m < 4; ++m)
#pragma unroll
                for (int n = 0; n < 2; ++n) acc[a][b][m][n] = (f32x4){0.f, 0.f, 0.f, 0.f};
    bf16x8 At[4][2], B0[2][2], B1[2][2];
    const char* cA = (const char*)g.A + (size_t)cur.pm * tstep; const char* cB = (const char*)g.Bt + (size_t)cur.pn * tstep;
    S.a_ready(cur);
    if constexpr (SP2) {
        PG8_STAGE(PG8_SB(0, 0), cB, voffB); PG8_STAGE(PG8_SB(0, 1), cB + hstepB, voffB); PG8_STAGE(PG8_SA(0, 0), cA, voffA); PG8_STAGE(PG8_SA(0, 1), cA + hstep, voffA);
        if (wr == 1) PG8_BAR;
        PG8_WAIT_V(2); PG8_BAR;
        PG8_STAGE(PG8_SB(1, 0), cB + kstep, voffB); PG8_STAGE(PG8_SA(1, 0), cA + kstep, voffA); PG8_STAGE(PG8_SB(1, 1), cB + hstepB + kstep, voffB);
        PG8_WAIT_V(6); PG8_BAR;
    } else {
        PG8_STAGE(PG8_SB(0, 0), cB, voffB); PG8_STAGE(PG8_SA(0, 0), cA, voffA); PG8_STAGE(PG8_SB(0, 1), cB + hstepB, voffB); PG8_STAGE(PG8_SA(0, 1), cA + hstep, voffA);
        if (wr == 1) PG8_BAR;
        PG8_WAIT_V(4); PG8_BAR;
        PG8_STAGE(PG8_SB(1, 0), cB + kstep, voffB); PG8_STAGE(PG8_SA(1, 0), cA + kstep, voffA); PG8_STAGE(PG8_SB(1, 1), cB + hstepB + kstep, voffB);
        PG8_WAIT_V(6); PG8_BAR;
    }
    for (;;) {
        const bool has_next = S.next(ui + 1, nxt);
        const char* nA = has_next ? (const char*)g.A + (size_t)nxt.pm * tstep : cA; const char* nB = has_next ? (const char*)g.Bt + (size_t)nxt.pn * tstep : cB;
        for (int t = 0; t < nt; t += 2) {
            const bool last = (t == nt - 2);
            if constexpr (Epi::HAS_MID) { if (t == (nt >> 1)) E.mid(acc, cur, wr, wc, fr, fq); }
            const char* a1 = cA + (size_t)(t + 1) * kstep;
            const char* a2 = last ? nA : cA + (size_t)(t + 2) * kstep; const char* b2 = last ? nB : cB + (size_t)(t + 2) * kstep;
            const char* a3 = a2 + kstep; const char* b3 = b2 + kstep;
            if (last && has_next) S.a_ready(nxt);
            if constexpr (SP2) {
            PG8_LDB(B0, 0, 0); PG8_LDB(B1, 0, 1); PG8_SCHED; PG8_LDA(At, 0, 0); PG8_STAGE(PG8_SA(1, 1), a1 + hstep, voffA);
            PG8_WAIT_V(8); PG8_WAIT_L(0); PG8_BAR; PG8_MMA(0, 0, At, B0); PG8_MMA(0, 1, At, B1); PG8_BAR; PG8_SCHED;
            PG8_LDA(At, 0, 1); PG8_STAGE(PG8_SB(0, 0), b2, voffB); PG8_STAGE(PG8_SB(0, 1), b2 + hstepB, voffB); PG8_STAGE(PG8_SA(0, 0), a2, voffA);
            PG8_WAIT_V(8); PG8_WAIT_L(0); PG8_BAR; PG8_MMA(1, 0, At, B0); PG8_MMA(1, 1, At, B1); PG8_BAR; PG8_SCHED;
            PG8_LDB(B0, 1, 0); PG8_LDB(B1, 1, 1); PG8_SCHED; PG8_LDA(At, 1, 0); PG8_STAGE(PG8_SA(0, 1), a2 + hstep, voffA);
            PG8_WAIT_V(8); PG8_WAIT_L(0); PG8_BAR; PG8_MMA(0, 0, At, B0); PG8_MMA(0, 1, At, B1); PG8_BAR; PG8_SCHED;
            PG8_LDA(At, 1, 1); PG8_STAGE(PG8_SB(1, 0), b3, voffB); PG8_STAGE(PG8_SB(1, 1), b3 + hstepB, voffB); PG8_STAGE(PG8_SA(1, 0), a3, voffA);
            PG8_WAIT_V(8); PG8_WAIT_L(0); PG8_BAR; PG8_MMA(1, 0, At, B0); PG8_MMA(1, 1, At, B1); PG8_BAR; PG8_SCHED;
            } else {
            PG8_LDB(B0, 0, 0); PG8_SCHED; PG8_LDA(At, 0, 0); PG8_STAGE(PG8_SA(1, 1), a1 + hstep, voffA);
            PG8_WAIT_L(8); PG8_BAR; PG8_WAIT_L(0); PG8_MMA(0, 0, At, B0); PG8_BAR; PG8_SCHED;
            PG8_LDB(B1, 0, 1); PG8_STAGE(PG8_SB(0, 0), b2, voffB);
            PG8_BAR; PG8_WAIT_L(0); PG8_MMA(0, 1, At, B1); PG8_BAR;
            PG8_LDA(At, 0, 1); PG8_STAGE(PG8_SA(0, 0), a2, voffA);
            PG8_BAR; PG8_WAIT_L(0); PG8_MMA(1, 0, At, B0); PG8_BAR; PG8_SCHED;
            PG8_STAGE(PG8_SB(0, 1), b2 + hstepB, voffB);
            PG8_WAIT_V(6); PG8_BAR; PG8_MMA(1, 1, At, B1); PG8_BAR;
            PG8_LDB(B0, 1, 0); PG8_SCHED; PG8_LDA(At, 1, 0); PG8_STAGE(PG8_SA(0, 1), a2 + hstep, voffA);
            PG8_WAIT_L(8); PG8_BAR; PG8_WAIT_L(0); PG8_MMA(0, 0, At, B0); PG8_BAR; PG8_SCHED;
            PG8_LDB(B1, 1, 1); PG8_STAGE(PG8_SB(1, 0), b3, voffB);
            PG8_BAR; PG8_WAIT_L(0); PG8_MMA(0, 1, At, B1); PG8_BAR;
            PG8_LDA(At, 1, 1); PG8_STAGE(PG8_SA(1, 0), a3, voffA);
            PG8_BAR; PG8_WAIT_L(0); PG8_MMA(1, 0, At, B0); PG8_BAR; PG8_SCHED;
            PG8_STAGE(PG8_SB(1, 1), b3 + hstepB, voffB);
            PG8_WAIT_V(6); PG8_BAR; PG8_MMA(1, 1, At, B1); PG8_BAR;
            }
        }
        if constexpr (ALIGN_EPI) { if (wr == 0) PG8_BAR; }
        if constexpr (!Epi::AFTER_DRAIN) { E(acc, cur, wr, wc, fr, fq); S.done(cur); }
        if (!has_next) break;
#pragma unroll
        for (int a = 0; a < 2; ++a)
#pragma unroll
            for (int b = 0; b < 2; ++b)
#pragma unroll
                for (int m = 0; m < 4; ++m)
#pragma unroll
                    for (int n = 0; n < 2; ++n) acc[a][b][m][n] = (f32x4){0.f, 0.f, 0.f, 0.f};
        cur = nxt; cA = nA; cB = nB; ++ui;
        if constexpr (ALIGN_EPI) { if (wr == 1) PG8_BAR; }
    }
    PG8_WAIT_V(0);
    if constexpr (!ALIGN_EPI) { if (wr == 0) PG8_BAR; }
    PG8_BAR;
    if constexpr (Epi::AFTER_DRAIN) { E.fused(acc, cur, wr, wc, fr, fq, lds, wid, lane); S.done(cur); }
#undef PG8_SA
#undef PG8_SB
#undef PG8_STAGE
#undef PG8_LDA
#undef PG8_LDB
#undef PG8_MMA
#undef PG8_WAIT_V
#undef PG8_WAIT_L
#undef PG8_BAR
#undef PG8_SCHED
}
}

constexpr int NWAVES = 8;
constexpr int D = 1024, TC = 8192, TL = 4096, T = TC + TL, DEPTH = 4, NIN = 3328, FF = 2816, NMOD = 6 * D;
constexpr int LKEYS = 1280;
constexpr float EPS = 1e-6f;
constexpr float QSCALE = 0.125f * 1.4426950408889634f;
constexpr size_t OUT_Y = 0, OUT_NK = (size_t)T * D, OUT_NV = OUT_NK + (size_t)32 * 4 * 256 * 128;

constexpr size_t MiB = 1u << 20;
constexpr size_t WS_CTL = 0, CTL_ZERO_BYTES = 1 * MiB;
constexpr int CW_BAR = 4096;
constexpr size_t WS_MOD = 512 * 1024;
constexpr size_t WS_ROPE = 1 * MiB;
constexpr size_t WS_W = 2 * MiB, W_LAYER = 28 * MiB;
constexpr size_t WO_IN = 0, WO_UP2 = 6815744, WO_OUT = WO_UP2 + 2 * MiB, WO_GU = WO_OUT + 2 * MiB, WO_DN = WO_GU + 11534336, WO_PT = WO_DN + 5767168;
static_assert(WO_PT + 131072 <= W_LAYER, "weights per layer");
constexpr size_t WS_KL = 114 * MiB, KL_LAYER = (size_t)4 * LKEYS * 128 * 2;
constexpr size_t WS_VTL = 119 * MiB;
constexpr size_t WS_KC = 124 * MiB, WS_VTC = 126 * MiB;
constexpr size_t WS_HA = 128 * MiB, WS_AP = 152 * MiB, WS_MIX = 176 * MiB, WS_MO = 200 * MiB, WS_G = 248 * MiB, WS_Q = 296 * MiB, WS_P = 308 * MiB, WS_HID = 248 * MiB, WS_END = 320 * MiB;
static_assert(WS_W + DEPTH * W_LAYER <= WS_KL && WS_KL + DEPTH * KL_LAYER <= WS_VTL && WS_VTL + DEPTH * KL_LAYER <= WS_KC, "ws map");
static_assert(WS_HID + (size_t)T * FF * 2 <= WS_END, "hid overlay");

constexpr int RING_BYTES = 131072, LDSCTL_OFF = RING_BYTES, MISC_OFF = LDSCTL_OFF + 320, LDS_BYTES = 147456;

#define GAS __attribute__((address_space(1)))
#define LAS __attribute__((address_space(3)))
typedef unsigned short bf16;
typedef unsigned v4u __attribute__((ext_vector_type(4)));
typedef unsigned v2u __attribute__((ext_vector_type(2)));
typedef float f32x4 __attribute__((ext_vector_type(4)));
typedef float f32x16 __attribute__((ext_vector_type(16)));
typedef short bf16x8 __attribute__((ext_vector_type(8)));
typedef GAS unsigned gu32;
#define RLX_AGENT __ATOMIC_RELAXED, __HIP_MEMORY_SCOPE_AGENT
#define LDS_WAIT() asm volatile("s_waitcnt lgkmcnt(0)" ::: "memory")

__device__ __forceinline__ unsigned cvtpk(float lo, float hi) { unsigned r; asm volatile("v_cvt_pk_bf16_f32 %0, %1, %2" : "=v"(r) : "v"(lo), "v"(hi)); return r; }
__device__ __forceinline__ float bflo(unsigned u) { return __uint_as_float(u << 16); }
__device__ __forceinline__ float bfhi(unsigned u) { return __uint_as_float(u & 0xffff0000u); }
__device__ __forceinline__ float fast_sigmoid(float x) { return __builtin_amdgcn_rcpf(1.0f + __builtin_amdgcn_exp2f(-1.4426950408889634f * x)); }
__device__ __forceinline__ float wave_sum(float v) {
#pragma unroll
    for (int o = 1; o < 64; o <<= 1) v += __shfl_xor(v, o);
    return v;
}
__device__ __forceinline__ int swap23(int k) { return (k & ~12) | ((k & 4) << 1) | ((k & 8) >> 1); }
__device__ __forceinline__ int mod_index(int row) { return row < TC ? 0 : 1 + ((row - TC) >> 10); }


struct EpiIn {
    static constexpr bool PERM = true, AFTER_DRAIN = false, NMAP64 = true, HAS_MID = false;
    bf16 *Q, *KC, *VTC, *KL, *VTL, *P, *G; float *nk, *nv; const float *qn, *kn, *rc, *rs; int layer;
    __device__ __forceinline__ void mid(f32x4 (&)[2][2][4][2], const pg8::Unit&, int, int, int, int) const {}
    __device__ __forceinline__ void operator()(const f32x4 (&acc)[2][2][4][2], const pg8::Unit& u, int wr, int wc, int fr, int fq) const {
        asm volatile("" : "+v"(fr), "+v"(fq));
        const int pn = u.pn; const int rowb = u.pm * 256 + wr * 64 + fr; const bool ctx = u.pm < 32;
        if (pn >= 3) {
            const bool gate = pn >= 5; bf16* dst = gate ? G : P; const int ld = gate ? 2048 : 512; const int col0 = (gate ? (pn - 5) : (pn - 3)) * 256 + wc * 64 + 8 * fq;
#pragma unroll
            for (int ai = 0; ai < 2; ++ai)
#pragma unroll
                for (int m = 0; m < 4; ++m) { const int row = rowb + ai * 128 + m * 16;
#pragma unroll
                    for (int bj = 0; bj < 2; ++bj) { f32x4 v0 = acc[ai][bj][m][0], v1 = acc[ai][bj][m][1];
                        if (gate) {
#pragma unroll
                            for (int e = 0; e < 4; ++e) { v0[e] = fast_sigmoid(v0[e]); v1[e] = fast_sigmoid(v1[e]); } }
                        v4u w; w.x = cvtpk(v0[0], v0[1]); w.y = cvtpk(v0[2], v0[3]); w.z = cvtpk(v1[0], v1[1]); w.w = cvtpk(v1[2], v1[3]);
                        *(GAS v4u*)(dst + (size_t)row * ld + col0 + 32 * bj) = w; } asm volatile("" ::: "memory"); }
        } else if (pn == 2 && wc >= 2) {
            const int kvh = wc - 2;
#pragma unroll
            for (int ai = 0; ai < 2; ++ai)
#pragma unroll
                for (int m = 0; m < 4; ++m) { const int row = rowb + ai * 128 + m * 16;
                    bf16* vt; int vld;
                    if (ctx) { const int b = row >> 8, s = row & 255; float* o = nv + ((size_t)((b * 4 + layer) * 256 + s)) * 128 + kvh * 64 + 8 * fq;
#pragma unroll
                        for (int bj = 0; bj < 2; ++bj) { *(GAS f32x4*)(o + 32 * bj) = acc[ai][bj][m][0]; *(GAS f32x4*)(o + 32 * bj + 4) = acc[ai][bj][m][1]; }
                        vt = VTC + (size_t)((b * 2 + kvh) * 64) * 256 + ((s & ~15) | swap23(s & 15)); vld = 256;
                    } else { const int b = (row - TC) >> 10, s = (row - TC) & 1023;
                        vt = VTL + (size_t)((b * 2 + kvh) * 64) * LKEYS + 256 + ((s & ~15) | swap23(s & 15)); vld = LKEYS; }
#pragma unroll
                    for (int bj = 0; bj < 2; ++bj)
#pragma unroll
                        for (int n = 0; n < 2; ++n) { const f32x4 v = acc[ai][bj][m][n]; const unsigned p0 = cvtpk(v[0], v[1]), p1 = cvtpk(v[2], v[3]); const int d = 32 * bj + 8 * fq + 4 * n;
                            *(GAS bf16*)(vt + (size_t)(d + 0) * vld) = (bf16)(p0 & 0xffffu); *(GAS bf16*)(vt + (size_t)(d + 1) * vld) = (bf16)(p0 >> 16);
                            *(GAS bf16*)(vt + (size_t)(d + 2) * vld) = (bf16)(p1 & 0xffffu); *(GAS bf16*)(vt + (size_t)(d + 3) * vld) = (bf16)(p1 >> 16); } asm volatile("" ::: "memory"); }
        } else {
            const bool isq = pn < 2; const float* w = isq ? qn : kn; const int head = isq ? 4 * pn + wc : wc;
            const f32x4 w00 = *(const GAS f32x4*)(w + 8 * fq), w01 = *(const GAS f32x4*)(w + 8 * fq + 4), w10 = *(const GAS f32x4*)(w + 32 + 8 * fq), w11 = *(const GAS f32x4*)(w + 36 + 8 * fq);
#pragma unroll
            for (int ai = 0; ai < 2; ++ai)
#pragma unroll
                for (int m = 0; m < 4; ++m) { const int row = rowb + ai * 128 + m * 16;
                    f32x4 a0 = acc[ai][0][m][0], a1 = acc[ai][0][m][1], b0 = acc[ai][1][m][0], b1 = acc[ai][1][m][1];
                    float ss = (a0[0] * a0[0] + a0[1] * a0[1]) + (a0[2] * a0[2] + a0[3] * a0[3]) + (a1[0] * a1[0] + a1[1] * a1[1]) + (a1[2] * a1[2] + a1[3] * a1[3])
                             + (b0[0] * b0[0] + b0[1] * b0[1]) + (b0[2] * b0[2] + b0[3] * b0[3]) + (b1[0] * b1[0] + b1[1] * b1[1]) + (b1[2] * b1[2] + b1[3] * b1[3]);
                    ss += __shfl_xor(ss, 16); ss += __shfl_xor(ss, 32);
                    const float r = 1.0f / sqrtf(ss * (1.0f / 64.0f) + EPS);
                    a0 = a0 * r * w00; a1 = a1 * r * w01; b0 = b0 * r * w10; b1 = b1 * r * w11;
                    if (!ctx) { const int s = (row - TC) & 1023;
                        const f32x4 c0 = *(const GAS f32x4*)(rc + s * 32 + 8 * fq), c1 = *(const GAS f32x4*)(rc + s * 32 + 8 * fq + 4), s0 = *(const GAS f32x4*)(rs + s * 32 + 8 * fq), s1 = *(const GAS f32x4*)(rs + s * 32 + 8 * fq + 4);
                        const f32x4 na0 = a0 * c0 - b0 * s0, nb0 = b0 * c0 + a0 * s0, na1 = a1 * c1 - b1 * s1, nb1 = b1 * c1 + a1 * s1; a0 = na0; b0 = nb0; a1 = na1; b1 = nb1; }
                    if (isq) { a0 = a0 * QSCALE; a1 = a1 * QSCALE; b0 = b0 * QSCALE; b1 = b1 * QSCALE; }
                    else if (ctx) { const int b = row >> 8, s = row & 255; float* o = nk + ((size_t)((b * 4 + layer) * 256 + s)) * 128 + head * 64 + 8 * fq;
                        *(GAS f32x4*)(o) = a0; *(GAS f32x4*)(o + 4) = a1; *(GAS f32x4*)(o + 32) = b0; *(GAS f32x4*)(o + 36) = b1; }
                    bf16* dst;
                    if (isq) dst = Q + (size_t)row * 512 + head * 64 + 8 * fq;
                    else if (ctx) dst = KC + (size_t)row * 128 + head * 64 + 8 * fq;
                    else { const int b = (row - TC) >> 10, s = (row - TC) & 1023; dst = KL + (size_t)(b * LKEYS + 256 + s) * 128 + head * 64 + 8 * fq; }
                    v4u wa, wb; wa.x = cvtpk(a0[0], a0[1]); wa.y = cvtpk(a0[2], a0[3]); wa.z = cvtpk(a1[0], a1[1]); wa.w = cvtpk(a1[2], a1[3]);
                    wb.x = cvtpk(b0[0], b0[1]); wb.y = cvtpk(b0[2], b0[3]); wb.z = cvtpk(b1[0], b1[1]); wb.w = cvtpk(b1[2], b1[3]);
                    *(GAS v4u*)(dst) = wa; *(GAS v4u*)(dst + 32) = wb; asm volatile("" ::: "memory"); }
        }
    }
};

struct EpiUp {
    static constexpr bool PERM = true, AFTER_DRAIN = false, NMAP64 = false, HAS_MID = true;
    const bf16* G; bf16* MIX;
    __device__ __forceinline__ void mid(f32x4 (&acc)[2][2][4][2], const pg8::Unit& u, int wr, int wc, int fr, int fq) const {
        asm volatile("" : "+v"(fr), "+v"(fq));
        const int rowb = u.pm * 256 + wr * 64 + fr, colb = u.pn * 256 + wc * 32 + 8 * fq;
#pragma unroll
        for (int ai = 0; ai < 2; ++ai)
#pragma unroll
            for (int m = 0; m < 4; ++m) { const bf16* gr = G + (size_t)(rowb + ai * 128 + m * 16) * 2048 + colb;
#pragma unroll
                for (int bj = 0; bj < 2; ++bj) { const v4u ga = *(const GAS v4u*)(gr + 128 * bj), gp = *(const GAS v4u*)(gr + 1024 + 128 * bj);
                    f32x4 r0, r1;
                    r0[0] = bflo(ga.x) * __builtin_amdgcn_rcpf(bflo(gp.x)); r0[1] = bfhi(ga.x) * __builtin_amdgcn_rcpf(bfhi(gp.x)); r0[2] = bflo(ga.y) * __builtin_amdgcn_rcpf(bflo(gp.y)); r0[3] = bfhi(ga.y) * __builtin_amdgcn_rcpf(bfhi(gp.y));
                    r1[0] = bflo(ga.z) * __builtin_amdgcn_rcpf(bflo(gp.z)); r1[1] = bfhi(ga.z) * __builtin_amdgcn_rcpf(bfhi(gp.z)); r1[2] = bflo(ga.w) * __builtin_amdgcn_rcpf(bflo(gp.w)); r1[3] = bfhi(ga.w) * __builtin_amdgcn_rcpf(bfhi(gp.w));
                    acc[ai][bj][m][0] = acc[ai][bj][m][0] * r0; acc[ai][bj][m][1] = acc[ai][bj][m][1] * r1; } asm volatile("" ::: "memory"); }
        asm volatile("s_waitcnt vmcnt(0)" ::: "memory"); __builtin_amdgcn_sched_barrier(0);
    }
    __device__ __forceinline__ void operator()(const f32x4 (&acc)[2][2][4][2], const pg8::Unit& u, int wr, int wc, int fr, int fq) const {
        asm volatile("" : "+v"(fr), "+v"(fq));
        const int rowb = u.pm * 256 + wr * 64 + fr, colb = u.pn * 256 + wc * 32 + 8 * fq;
#pragma unroll
        for (int ai = 0; ai < 2; ++ai)
#pragma unroll
            for (int m = 0; m < 4; ++m) { const int row = rowb + ai * 128 + m * 16; const bf16* gr = G + (size_t)row * 2048 + 1024 + colb;
#pragma unroll
                for (int bj = 0; bj < 2; ++bj) { const v4u gp = *(const GAS v4u*)(gr + 128 * bj); const f32x4 v0 = acc[ai][bj][m][0], v1 = acc[ai][bj][m][1];
                    v4u w; w.x = cvtpk(v0[0] * bflo(gp.x), v0[1] * bfhi(gp.x)); w.y = cvtpk(v0[2] * bflo(gp.y), v0[3] * bfhi(gp.y));
                    w.z = cvtpk(v1[0] * bflo(gp.z), v1[1] * bfhi(gp.z)); w.w = cvtpk(v1[2] * bflo(gp.w), v1[3] * bfhi(gp.w));
                    *(GAS v4u*)(MIX + (size_t)row * 1024 + colb + 128 * bj) = w; } asm volatile("" ::: "memory"); }
    }
};

struct EpiGU {
    static constexpr bool PERM = true, AFTER_DRAIN = false, NMAP64 = false, HAS_MID = false;
    bf16* HID;
    __device__ __forceinline__ void mid(f32x4 (&)[2][2][4][2], const pg8::Unit&, int, int, int, int) const {}
    __device__ __forceinline__ void operator()(const f32x4 (&acc)[2][2][4][2], const pg8::Unit& u, int wr, int wc, int fr, int fq) const {
        asm volatile("" : "+v"(fr), "+v"(fq));
        const int rowb = u.pm * 256 + wr * 64 + fr, col = u.pn * 128 + wc * 32 + 8 * fq;
#pragma unroll
        for (int ai = 0; ai < 2; ++ai)
#pragma unroll
            for (int m = 0; m < 4; ++m) { const int row = rowb + ai * 128 + m * 16;
                const f32x4 g0 = acc[ai][0][m][0], g1 = acc[ai][0][m][1], u0 = acc[ai][1][m][0], u1 = acc[ai][1][m][1]; float h[8];
#pragma unroll
                for (int e = 0; e < 4; ++e) { h[e] = g0[e] * fast_sigmoid(g0[e]) * u0[e]; h[4 + e] = g1[e] * fast_sigmoid(g1[e]) * u1[e]; }
                v4u w; w.x = cvtpk(h[0], h[1]); w.y = cvtpk(h[2], h[3]); w.z = cvtpk(h[4], h[5]); w.w = cvtpk(h[6], h[7]);
                *(GAS v4u*)(HID + (size_t)row * FF + col) = w; }
    }
};

struct EpiF32 {
    static constexpr bool PERM = false, AFTER_DRAIN = false, NMAP64 = false, HAS_MID = false;
    float* C;
    __device__ __forceinline__ void mid(f32x4 (&)[2][2][4][2], const pg8::Unit&, int, int, int, int) const {}
    __device__ __forceinline__ void operator()(const f32x4 (&acc)[2][2][4][2], const pg8::Unit& u, int wr, int wc, int fr, int fq) const {
        asm volatile("" : "+v"(fr), "+v"(fq));
        const int row0 = u.pm * 256 + wr * 64 + fr, col0 = u.pn * 256 + wc * 32 + 4 * fq;
#pragma unroll
        for (int ai = 0; ai < 2; ++ai)
#pragma unroll
            for (int m = 0; m < 4; ++m) { float* rowp = C + (size_t)(row0 + ai * 128 + m * 16) * D + col0;
#pragma unroll
                for (int bj = 0; bj < 2; ++bj)
#pragma unroll
                    for (int n = 0; n < 2; ++n) *(GAS f32x4*)(rowp + bj * 128 + n * 16) = acc[ai][bj][m][n]; }
    }
};

#define XB_TMO      128
#define XB_XCNT(j)  (256  + 64 * (j))
#define XB_XSUB(j)  (1280 + 64 * (j))
#define XB_XGEN(j)  (2304 + 64 * (j))
#define XB_TOP      3328
#define XB_TOPGEN   3392
#define XCD_BAR_WORDS 3456
#define XB_SPIN_CAP (1u << 18)

__device__ __forceinline__ unsigned xb_ld(unsigned* p)              { return __hip_atomic_load(p, __ATOMIC_RELAXED, __HIP_MEMORY_SCOPE_AGENT); }
__device__ __forceinline__ unsigned xb_add(unsigned* p, unsigned v) { return __hip_atomic_fetch_add(p, v, __ATOMIC_RELAXED, __HIP_MEMORY_SCOPE_AGENT); }
__device__ __forceinline__ unsigned xb_xcc_id() { return (unsigned)__builtin_amdgcn_s_getreg((3 << 11) | 20) & 0xFu; }
#define XB_SPIN(cond, bar) do { unsigned _sp = 0; while (cond) { __builtin_amdgcn_s_sleep(1); \
    if ((++_sp & 255u) == 0u) { if (xb_ld(&(bar)[XB_TMO])) break; if (_sp > XB_SPIN_CAP) { atomicAdd(&(bar)[XB_TMO], 1u); break; } } } } while (0)

struct XcdBarrier {
    unsigned* bar; unsigned x;
    volatile LAS unsigned* st;
};

__device__ __forceinline__ XcdBarrier xcd_barrier_post(unsigned* bar, volatile LAS unsigned* st) {
    XcdBarrier b; b.bar = bar; b.x = xb_xcc_id(); b.st = st;
    if (threadIdx.x == 0) (void)xb_add(&bar[XB_XCNT(b.x)], 1u);
    return b;
}
__device__ __forceinline__ void xcd_barrier_complete(unsigned* bar, unsigned x, unsigned& nloc, unsigned& nx) {
    const unsigned G = gridDim.x * gridDim.y * gridDim.z;
    unsigned sum, cnt, mine, sp = 0u;
    for (;;) {
        sum = 0u; cnt = 0u; mine = 0u;
#pragma unroll
        for (unsigned j = 0; j < 16; ++j) { const unsigned c = xb_ld(&bar[XB_XCNT(j)]); sum += c; cnt += (c > 0u) ? 1u : 0u; mine = (j == x) ? c : mine; }
        if (sum == G) break;
        __builtin_amdgcn_s_sleep(1);
        if ((++sp & 255u) == 0u) { if (xb_ld(&bar[XB_TMO])) break; if (sp > XB_SPIN_CAP) { atomicAdd(&bar[XB_TMO], 1u); break; } }
    }
    nloc = mine > 0u ? mine : 1u; nx = cnt > 0u ? cnt : 1u;
}

__device__ __forceinline__ void xcd_barrier(const XcdBarrier& b) {
    asm volatile("s_waitcnt vmcnt(0)" ::: "memory");
    __syncthreads();
    if (threadIdx.x == 0) {
        unsigned* bar = b.bar;
        __builtin_amdgcn_s_waitcnt(0);
        unsigned nloc = b.st[0], nx = b.st[1];
        if (nloc == 0u) { xcd_barrier_complete(bar, b.x, nloc, nx); b.st[0] = nloc; b.st[1] = nx; }
        const unsigned old = xb_add(&bar[XB_XSUB(b.x)], 1u);
        const unsigned gen = old / nloc;
        if (old + 1u == (gen + 1u) * nloc) {
            __builtin_amdgcn_fence(__ATOMIC_RELEASE, "agent");
            asm volatile("s_waitcnt vmcnt(0)" ::: "memory");
            const unsigned og = xb_add(&bar[XB_TOP], 1u);
            const unsigned tg = og / nx;
            if (og + 1u == (tg + 1u) * nx) xb_add(&bar[XB_TOPGEN], 1u);
            else XB_SPIN(xb_ld(&bar[XB_TOPGEN]) == tg, bar);
            __builtin_amdgcn_fence(__ATOMIC_ACQUIRE, "agent");
            xb_add(&bar[XB_XGEN(b.x)], 1u);
            asm volatile("s_waitcnt vmcnt(0)" ::: "memory");
        } else {
            XB_SPIN(xb_ld(&bar[XB_XGEN(b.x)]) == gen, bar);
            __builtin_amdgcn_fence(__ATOMIC_ACQUIRE, "agent");
            asm volatile("s_waitcnt vmcnt(0)" ::: "memory");
        }
    }
    __syncthreads();
}

struct Args { const float* in[23]; float* out; unsigned char* ws; };

struct Frame {
    LAS unsigned char* lds; int tid, lane, wave, vcu, G, gw, ngw;
    float* out; unsigned char* ws;
};

__device__ __forceinline__ void transpose_item(const float* W, int N, bf16* WT, int ldd, int drow0, int dcol0, LAS float* scr, int k0, int n0, int lane) {
#pragma unroll 8
    for (int i = 0; i < 32; ++i) { const int kk = 2 * i + (lane >> 5); scr[kk * 33 + (lane & 31)] = W[(size_t)(k0 + kk) * N + n0 + (lane & 31)]; }
    LDS_WAIT(); asm volatile("" ::: "memory");
    const int c = lane & 7;
#pragma unroll
    for (int j = 0; j < 4; ++j) { const int n = (lane >> 3) + 8 * j; const LAS float* s = scr + (8 * c) * 33 + n;
        v4u o; o.x = cvtpk(s[0 * 33], s[1 * 33]); o.y = cvtpk(s[2 * 33], s[3 * 33]); o.z = cvtpk(s[4 * 33], s[5 * 33]); o.w = cvtpk(s[6 * 33], s[7 * 33]);
        *(GAS v4u*)(WT + (size_t)(drow0 + n) * ldd + dcol0 + k0 + 8 * c) = o; }
    LDS_WAIT(); asm volatile("" ::: "memory");
}

__device__ __forceinline__ float silu_f(float x) { return x / (1.0f + __expf(-x)); }

__device__ __forceinline__ void mod_item(Frame& F, const Args& A, int item) {
    typedef float f32x2 __attribute__((ext_vector_type(2)));
    const int cc = item % 48, l = item / 48; const int k0 = F.wave * 128, c0 = cc * 128 + F.lane * 2;
    float sv[2][5];
#pragma unroll
    for (int h = 0; h < 2; ++h) { sv[h][0] = silu_f(A.in[5][k0 + 64 * h + F.lane]);
#pragma unroll
        for (int b = 0; b < 4; ++b) sv[h][1 + b] = silu_f(A.in[4][b * D + k0 + 64 * h + F.lane]); }
    f32x2 acc[5];
#pragma unroll
    for (int mi = 0; mi < 5; ++mi) acc[mi] = (f32x2){0.f, 0.f};
    const float* wp = A.in[6] + ((size_t)l * D + k0) * NMOD + c0;
#pragma unroll
    for (int h = 0; h < 2; ++h)
#pragma unroll 16
        for (int kk = 0; kk < 64; ++kk) { const f32x2 w = *(const GAS f32x2*)(wp + (size_t)(64 * h + kk) * NMOD);
#pragma unroll
            for (int mi = 0; mi < 5; ++mi) { const float s = __uint_as_float(__builtin_amdgcn_readlane(__float_as_uint(sv[h][mi]), kk)); acc[mi] = acc[mi] + w * s; } }
    LAS float* part = (LAS float*)F.lds;
#pragma unroll
    for (int mi = 0; mi < 5; ++mi) *(LAS f32x2*)(part + (F.wave * 5 + mi) * 128 + F.lane * 2) = acc[mi];
    __syncthreads();
    for (int o = F.tid; o < 5 * 128; o += NWAVES * 64) { const int mi = o >> 7, c = o & 127; float s = A.in[7][(size_t)l * NMOD + cc * 128 + c];
#pragma unroll
        for (int w = 0; w < 8; ++w) s += part[(w * 5 + mi) * 128 + c];
        ((float*)(F.ws + WS_MOD))[((size_t)l * 5 + mi) * NMOD + cc * 128 + c] = s; }
    __syncthreads();
}

__device__ __forceinline__ void sincos_tab(float ang, float& sn, float& cs) {
    const double a = (double)ang; const double q = __builtin_rint(a * 0.63661977236758134308); const double r = a - q * 1.57079632679489661923; const double r2 = r * r;
    const double s = r * (1.0 + r2 * (-1.0 / 6 + r2 * (1.0 / 120 + r2 * (-1.0 / 5040 + r2 * (1.0 / 362880 + r2 * (-1.0 / 39916800 + r2 * (1.0 / 6227020800.0)))))));
    const double c = 1.0 + r2 * (-0.5 + r2 * (1.0 / 24 + r2 * (-1.0 / 720 + r2 * (1.0 / 40320 + r2 * (-1.0 / 3628800 + r2 * (1.0 / 479001600 + r2 * (-1.0 / 87178291200.0)))))));
    const int qi = ((int)q) & 3;
    const double ss = (qi == 0) ? s : (qi == 1) ? c : (qi == 2) ? -s : -c;
    const double cc = (qi == 0) ? c : (qi == 1) ? -s : (qi == 2) ? -c : s;
    sn = (float)ss; cs = (float)cc;
}

__device__ __forceinline__ void prologue(Frame& F, const Args& A) {
    LAS float* scr = (LAS float*)(F.lds + F.wave * 16384);
    constexpr int I_IN = 16 * 104, I_AU = 8 * 32, I_PU = 8 * 32, I_OUT = 16 * 32, I_G = 16 * 88, I_U = 16 * 88, I_DN = 44 * 32, I_PW = 4 * 2 * 4;
    constexpr int I_LAYER = I_IN + I_AU + I_PU + I_OUT + I_G + I_U + I_DN + I_PW;
    for (int it = F.gw; it < DEPTH * I_LAYER; it += F.ngw) {
        const int l = it / I_LAYER; int r = it % I_LAYER; unsigned char* wl = F.ws + WS_W + (size_t)l * W_LAYER;
        if (r < I_IN) { const int kb = r / 104, nb = r % 104; transpose_item(A.in[8] + (size_t)l * D * NIN, NIN, (bf16*)(wl + WO_IN), D, 32 * nb, 0, scr, 64 * kb, 32 * nb, F.lane); continue; } r -= I_IN;
        if (r < I_AU) { const int kb = r / 32, nb = r % 32; transpose_item(A.in[11] + (size_t)l * 512 * D, D, (bf16*)(wl + WO_UP2), D, 32 * nb, 0, scr, 64 * kb, 32 * nb, F.lane); continue; } r -= I_AU;
        if (r < I_PU) { const int kb = r / 32, nb = r % 32; transpose_item(A.in[14] + (size_t)l * 512 * D, D, (bf16*)(wl + WO_UP2), D, 32 * nb, 512, scr, 64 * kb, 32 * nb, F.lane); continue; } r -= I_PU;
        if (r < I_OUT) { const int kb = r / 32, nb = r % 32; transpose_item(A.in[15] + (size_t)l * D * D, D, (bf16*)(wl + WO_OUT), D, 32 * nb, 0, scr, 64 * kb, 32 * nb, F.lane); continue; } r -= I_OUT;
        if (r < I_G) { const int kb = r / 88, nb = r % 88, n0 = 32 * nb; transpose_item(A.in[20] + (size_t)l * D * FF, FF, (bf16*)(wl + WO_GU), D, 256 * (n0 >> 7) + (n0 & 127), 0, scr, 64 * kb, n0, F.lane); continue; } r -= I_G;
        if (r < I_U) { const int kb = r / 88, nb = r % 88, n0 = 32 * nb; transpose_item(A.in[21] + (size_t)l * D * FF, FF, (bf16*)(wl + WO_GU), D, 256 * (n0 >> 7) + 128 + (n0 & 127), 0, scr, 64 * kb, n0, F.lane); continue; } r -= I_U;
        if (r < I_DN) { const int kb = r / 32, nb = r % 32; transpose_item(A.in[22] + (size_t)l * FF * D, D, (bf16*)(wl + WO_DN), FF, 32 * nb, 0, scr, 64 * kb, 32 * nb, F.lane); continue; } r -= I_DN;
        { const int g = r / 8, kb = (r % 8) / 4, nb = r % 4; transpose_item(A.in[12] + ((size_t)l * 4 + g) * 128 * 128, 128, (bf16*)(wl + WO_PT) + (size_t)g * 128 * 128, 128, 32 * nb, 0, scr, 64 * kb, 32 * nb, F.lane); }
    }
    __syncthreads();
    for (int it = F.vcu; it < DEPTH * 48; it += F.G) mod_item(F, A, it);
    const int gt = F.vcu * 512 + F.tid, ngt = F.G * 512;
    for (int i = gt; i < 4 * DEPTH * 256 * 16; i += ngt) {
        const int c8 = i & 15, key = (i >> 4) & 255, l = (i >> 12) & 3, b = i >> 14;
        const float* src = A.in[2] + (((size_t)(b * DEPTH + l) * 256 + key) * 128 + c8 * 8);
        const f32x4 a = *(const GAS f32x4*)src, c = *(const GAS f32x4*)(src + 4);
        v4u w; w.x = cvtpk(a[0], a[1]); w.y = cvtpk(a[2], a[3]); w.z = cvtpk(c[0], c[1]); w.w = cvtpk(c[2], c[3]);
        *(GAS v4u*)((bf16*)(F.ws + WS_KL + (size_t)l * KL_LAYER) + (size_t)(b * LKEYS + key) * 128 + c8 * 8) = w;
    }
    for (int i = gt; i < 4 * DEPTH * 128 * 32; i += ngt) {
        const int p8 = i & 31, ch = (i >> 5) & 127, l = (i >> 12) & 3, b = i >> 14;
        const float* src = A.in[3] + ((size_t)(b * DEPTH + l) * 256) * 128 + ch;
        float v[8];
#pragma unroll
        for (int j = 0; j < 8; ++j) { const int p = p8 * 8 + j; const int key = (p & ~15) | swap23(p & 15); v[j] = src[(size_t)key * 128]; }
        v4u w; w.x = cvtpk(v[0], v[1]); w.y = cvtpk(v[2], v[3]); w.z = cvtpk(v[4], v[5]); w.w = cvtpk(v[6], v[7]);
        *(GAS v4u*)((bf16*)(F.ws + WS_VTL + (size_t)l * KL_LAYER) + (size_t)((b * 2) * 64 + ch) * LKEYS + p8 * 8) = w;
    }
    for (int i = gt; i < 1024 * 32; i += ngt) {
        const int s = i >> 5, k = i & 31, f = k & 15; const int pos = (k < 16) ? (s >> 6) : (s & 63);
        const float inv = __builtin_amdgcn_exp2f(-(float)f * (13.287712379549449f / 16.0f));
        float sn, cs; sincos_tab((float)pos * inv, sn, cs);
        ((float*)(F.ws + WS_ROPE))[i] = cs; ((float*)(F.ws + WS_ROPE))[1024 * 32 + i] = sn;
    }
}

__device__ __forceinline__ const float* x_in_row(const Args& A, int row) { return row < TC ? A.in[0] + (size_t)row * D : A.in[1] + (size_t)(row - TC) * D; }

__device__ __forceinline__ void norm_mod_store(Frame& F, const f32x4 (&x)[4], const float* gain, const float* sc, const float* sh, bf16* orow) {
    float s = 0.f;
#pragma unroll
    for (int j = 0; j < 4; ++j) s += (x[j][0] * x[j][0] + x[j][1] * x[j][1]) + (x[j][2] * x[j][2] + x[j][3] * x[j][3]);
    const float rstd = 1.0f / sqrtf(wave_sum(s) * (1.0f / D) + EPS);
#pragma unroll
    for (int j = 0; j < 4; ++j) { const int c = 4 * F.lane + 256 * j;
        const f32x4 g = *(const GAS f32x4*)(gain + c), a = *(const GAS f32x4*)(sc + c), b = *(const GAS f32x4*)(sh + c);
        const f32x4 h = x[j] * rstd * g * (a + 1.0f) + b;
        v2u w; w.x = cvtpk(h[0], h[1]); w.y = cvtpk(h[2], h[3]); *(GAS v2u*)(orow + c) = w; }
}

__device__ __forceinline__ void rowpass_first(Frame& F, const Args& A) {
    const float* mod = (const float*)(F.ws + WS_MOD);
    for (int row = F.gw; row < T; row += F.ngw) { const float* xr = x_in_row(A, row); f32x4 x[4];
#pragma unroll
        for (int j = 0; j < 4; ++j) x[j] = *(const GAS f32x4*)(xr + 4 * F.lane + 256 * j);
        const float* m = mod + (size_t)mod_index(row) * NMOD;
        norm_mod_store(F, x, A.in[16], m + 1 * D, m + 0 * D, (bf16*)(F.ws + WS_HA) + (size_t)row * D); }
}

__device__ __forceinline__ void rowpass(Frame& F, const Args& A, bool x_from_input, const float* post_gain, const float* modl, int gate_off, const float* next_gain, const float* next_modl, int next_sc_off, int next_sh_off) {
    const float* Y = (const float*)(F.ws + WS_MO); float* X = F.out + OUT_Y;
    for (int row = F.gw; row < T; row += F.ngw) {
        const float* xr = x_from_input ? x_in_row(A, row) : X + (size_t)row * D; const float* yr = Y + (size_t)row * D; const int mi = mod_index(row);
        f32x4 x[4], y[4]; float s = 0.f;
#pragma unroll
        for (int j = 0; j < 4; ++j) { x[j] = *(const GAS f32x4*)(xr + 4 * F.lane + 256 * j); y[j] = *(const GAS f32x4*)(yr + 4 * F.lane + 256 * j);
            s += (y[j][0] * y[j][0] + y[j][1] * y[j][1]) + (y[j][2] * y[j][2] + y[j][3] * y[j][3]); }
        const float rstd = 1.0f / sqrtf(wave_sum(s) * (1.0f / D) + EPS);
        const float* gate = modl + (size_t)mi * NMOD + gate_off;
#pragma unroll
        for (int j = 0; j < 4; ++j) { const int c = 4 * F.lane + 256 * j; const f32x4 g = *(const GAS f32x4*)(gate + c), pg = *(const GAS f32x4*)(post_gain + c);
            x[j] = x[j] + g * (y[j] * rstd * pg); *(GAS f32x4*)(X + (size_t)row * D + c) = x[j]; }
        if (next_gain) { const float* m = next_modl + (size_t)mi * NMOD; norm_mod_store(F, x, next_gain, m + next_sc_off, m + next_sh_off, (bf16*)(F.ws + WS_HA) + (size_t)row * D); }
    }
}

__device__ __forceinline__ void attn_unit(const bf16* Qr, const bf16* Kb, const bf16* VTb, int vld, int nkt, bf16* Or, int lane) {
    const int r = lane & 31, hh = lane >> 5;
    bf16x8 qf[4];
#pragma unroll
    for (int ks = 0; ks < 4; ++ks) qf[ks] = *(const GAS bf16x8*)(Qr + (size_t)r * 512 + 16 * ks + 8 * hh);
    f32x16 o0, o1;
#pragma unroll
    for (int i = 0; i < 16; ++i) { o0[i] = 0.f; o1[i] = 0.f; }
    float mrun = -1e30f, lrun = 0.f;
    const bf16* kp = Kb + (size_t)r * 128 + 8 * hh; const bf16* vp = VTb + (size_t)r * vld + 8 * hh;
    bf16x8 kf[4], vf[4], kn[4], vn[4];
#pragma unroll
    for (int ks = 0; ks < 4; ++ks) kf[ks] = *(const GAS bf16x8*)(kp + 16 * ks);
#pragma unroll
    for (int i = 0; i < 4; ++i) vf[i] = *(const GAS bf16x8*)(vp + (size_t)(i >> 1) * 32 * vld + 16 * (i & 1));
    for (int kt = 0; kt < nkt; ++kt) {
        const int ktn = (kt + 1 < nkt) ? kt + 1 : kt;
#pragma unroll
        for (int ks = 0; ks < 4; ++ks) kn[ks] = *(const GAS bf16x8*)(kp + (size_t)ktn * 32 * 128 + 16 * ks);
#pragma unroll
        for (int i = 0; i < 4; ++i) vn[i] = *(const GAS bf16x8*)(vp + (size_t)(i >> 1) * 32 * vld + ktn * 32 + 16 * (i & 1));
        f32x16 s;
#pragma unroll
        for (int i = 0; i < 16; ++i) s[i] = 0.f;
#pragma unroll
        for (int ks = 0; ks < 4; ++ks) s = __builtin_amdgcn_mfma_f32_32x32x16_bf16(kf[ks], qf[ks], s, 0, 0, 0);
        float mx = s[0];
#pragma unroll
        for (int i = 1; i < 16; ++i) mx = fmaxf(mx, s[i]);
        mx = fmaxf(mx, __shfl_xor(mx, 32));
        const float mnew = fmaxf(mrun, mx), alpha = __builtin_amdgcn_exp2f(mrun - mnew);
        float rsum = 0.f;
#pragma unroll
        for (int i = 0; i < 16; ++i) { s[i] = __builtin_amdgcn_exp2f(s[i] - mnew); rsum += s[i]; }
        lrun = lrun * alpha + rsum; mrun = mnew;
#pragma unroll
        for (int i = 0; i < 16; ++i) { o0[i] *= alpha; o1[i] *= alpha; }
        v4u p0, p1;
        p0.x = cvtpk(s[0], s[1]); p0.y = cvtpk(s[2], s[3]); p0.z = cvtpk(s[4], s[5]); p0.w = cvtpk(s[6], s[7]);
        p1.x = cvtpk(s[8], s[9]); p1.y = cvtpk(s[10], s[11]); p1.z = cvtpk(s[12], s[13]); p1.w = cvtpk(s[14], s[15]);
        const bf16x8 pb0 = __builtin_bit_cast(bf16x8, p0), pb1 = __builtin_bit_cast(bf16x8, p1);
        o0 = __builtin_amdgcn_mfma_f32_32x32x16_bf16(vf[0], pb0, o0, 0, 0, 0); o0 = __builtin_amdgcn_mfma_f32_32x32x16_bf16(vf[1], pb1, o0, 0, 0, 0);
        o1 = __builtin_amdgcn_mfma_f32_32x32x16_bf16(vf[2], pb0, o1, 0, 0, 0); o1 = __builtin_amdgcn_mfma_f32_32x32x16_bf16(vf[3], pb1, o1, 0, 0, 0);
#pragma unroll
        for (int i = 0; i < 4; ++i) { kf[i] = kn[i]; vf[i] = vn[i]; }
    }
    lrun += __shfl_xor(lrun, 32);
    const float inv = 1.0f / lrun;
    bf16* op = Or + (size_t)r * D + 4 * hh;
#pragma unroll
    for (int g4 = 0; g4 < 4; ++g4) {
        v2u w; w.x = cvtpk(o0[4 * g4] * inv, o0[4 * g4 + 1] * inv); w.y = cvtpk(o0[4 * g4 + 2] * inv, o0[4 * g4 + 3] * inv); *(GAS v2u*)(op + 8 * g4) = w;
        v2u z; z.x = cvtpk(o1[4 * g4] * inv, o1[4 * g4 + 1] * inv); z.y = cvtpk(o1[4 * g4 + 2] * inv, o1[4 * g4 + 3] * inv); *(GAS v2u*)(op + 32 + 8 * g4) = z; }
}

template <int W>
__device__ __forceinline__ void pool_unit(const bf16* P, const bf16* WpT, const float* pscale, bf16* AP, int tb, int g, int lane) {
    const int r = lane & 31, hh = lane >> 5; const int row0 = tb * 32;
    int n, seq0; if (row0 < TC) { n = 256; seq0 = row0 & ~255; } else { n = 1024; seq0 = TC + ((row0 - TC) & ~1023); }
    const int t = row0 + r, s = t - seq0; constexpr int LEFT = W / 2, RIGHT = W - 1 - LEFT;
    const int lo = max(s - LEFT, 0), hi = min(s + RIGHT + 1, n); const float inv = 1.0f / (float)(hi - lo);
    bf16x8 df[8];
#pragma unroll
    for (int ks = 0; ks < 8; ++ks) { const bf16* pc = P + g * 128 + 16 * ks + 8 * hh; float a[8];
#pragma unroll
        for (int j = 0; j < 8; ++j) a[j] = 0.f;
#pragma unroll
        for (int dl = -LEFT; dl <= RIGHT; ++dl) { const int rr = s + dl; const bool ok = rr >= 0 && rr < n; const int rc = ok ? rr : s; const float wgt = ok ? 1.0f : 0.0f;
            const v4u v = *(const GAS v4u*)(pc + (size_t)(seq0 + rc) * 512);
            a[0] += wgt * bflo(v.x); a[1] += wgt * bfhi(v.x); a[2] += wgt * bflo(v.y); a[3] += wgt * bfhi(v.y); a[4] += wgt * bflo(v.z); a[5] += wgt * bfhi(v.z); a[6] += wgt * bflo(v.w); a[7] += wgt * bfhi(v.w); }
        const v4u sv = *(const GAS v4u*)(pc + (size_t)t * 512);
        v4u dw; dw.x = cvtpk(a[0] * inv - bflo(sv.x), a[1] * inv - bfhi(sv.x)); dw.y = cvtpk(a[2] * inv - bflo(sv.y), a[3] * inv - bfhi(sv.y));
        dw.z = cvtpk(a[4] * inv - bflo(sv.z), a[5] * inv - bfhi(sv.z)); dw.w = cvtpk(a[6] * inv - bflo(sv.w), a[7] * inv - bfhi(sv.w));
        df[ks] = __builtin_bit_cast(bf16x8, dw); }
    bf16* orow = AP + (size_t)t * D + 512 + g * 128 + 4 * hh;
#pragma unroll
    for (int nt = 0; nt < 4; ++nt) { f32x16 c;
#pragma unroll
        for (int i = 0; i < 16; ++i) c[i] = 0.f;
#pragma unroll
        for (int ks = 0; ks < 8; ++ks) { const bf16x8 a = *(const GAS bf16x8*)(WpT + (size_t)(g * 128 + 32 * nt + r) * 128 + 16 * ks + 8 * hh); c = __builtin_amdgcn_mfma_f32_32x32x16_bf16(a, df[ks], c, 0, 0, 0); }
#pragma unroll
        for (int g4 = 0; g4 < 4; ++g4) { const f32x4 sc = *(const GAS f32x4*)(pscale + g * 128 + 32 * nt + 8 * g4 + 4 * hh);
            v2u w; w.x = cvtpk(c[4 * g4] * sc[0], c[4 * g4 + 1] * sc[1]); w.y = cvtpk(c[4 * g4 + 2] * sc[2], c[4 * g4 + 3] * sc[3]); *(GAS v2u*)(orow + 32 * nt + 8 * g4) = w; } }
}

__device__ __forceinline__ void mix_phase(Frame& F, const Args& A, int l) {
    const bf16* Q = (const bf16*)(F.ws + WS_Q); bf16* AP = (bf16*)(F.ws + WS_AP);
    const int c = F.vcu, w = F.wave;
    if (w < 4) {
        const int b = c >> 6, kvh = (c >> 5) & 1, qb = c & 31, head = kvh * 4 + w; const int q0 = TC + b * 1024 + qb * 32;
        attn_unit(Q + (size_t)q0 * 512 + head * 64, (const bf16*)(F.ws + WS_KL + (size_t)l * KL_LAYER) + (size_t)(b * LKEYS) * 128 + kvh * 64,
                  (const bf16*)(F.ws + WS_VTL + (size_t)l * KL_LAYER) + (size_t)((b * 2 + kvh) * 64) * LKEYS, LKEYS, LKEYS / 32, AP + (size_t)q0 * D + head * 64, F.lane);
    } else {
        const int b = c >> 3, qb = c & 7; const int q0 = b * 256 + qb * 32;
#pragma unroll 1
        for (int i = 0; i < 2; ++i) { const int head = (w - 4) + 4 * i, kvh = i;
            attn_unit(Q + (size_t)q0 * 512 + head * 64, (const bf16*)(F.ws + WS_KC) + (size_t)(b * 256) * 128 + kvh * 64,
                      (const bf16*)(F.ws + WS_VTC) + (size_t)((b * 2 + kvh) * 64) * 256, 256, 8, AP + (size_t)q0 * D + head * 64, F.lane); }
        const bf16* P = (const bf16*)(F.ws + WS_P); const bf16* WpT = (const bf16*)(F.ws + WS_W + (size_t)l * W_LAYER + WO_PT); const float* ps = A.in[13] + (size_t)l * 512;
#pragma unroll 1
        for (int u = c * 6 + (w - 4); u < c * 6 + 6; u += 4) { const int tb = u >> 2, g = u & 3;
            if (g == 0) pool_unit<2>(P, WpT, ps, AP, tb, g, F.lane); else if (g == 1) pool_unit<4>(P, WpT, ps, AP, tb, g, F.lane);
            else if (g == 2) pool_unit<8>(P, WpT, ps, AP, tb, g, F.lane); else pool_unit<16>(P, WpT, ps, AP, tb, g, F.lane); }
    }
}

__global__ void __launch_bounds__(NWAVES * 64, 2) fwd_kernel(Args A) {
    extern __shared__ __attribute__((aligned(16))) unsigned char lds_raw[];
    Frame F;
    F.lds = (LAS unsigned char*)lds_raw;
    F.tid = threadIdx.x; F.lane = F.tid & 63; F.wave = __builtin_amdgcn_readfirstlane(F.tid >> 6);
    F.G = gridDim.x; { const int bx = blockIdx.x; F.vcu = (F.G % 8 == 0) ? (bx % 8) * (F.G / 8) + bx / 8 : bx; }
    F.gw = F.vcu * NWAVES + F.wave; F.ngw = F.G * NWAVES;
    F.out = A.out; F.ws = A.ws;
    for (int u = F.tid; u < (LDS_BYTES - LDSCTL_OFF) / 4; u += NWAVES * 64) ((LAS unsigned*)(F.lds + LDSCTL_OFF))[u] = 0u;
    __syncthreads();
    XcdBarrier bar = xcd_barrier_post((unsigned*)(F.ws + WS_CTL) + CW_BAR, (volatile LAS unsigned*)(F.lds + MISC_OFF) + 8);
#define GRID_BAR() do { xcd_barrier(bar); int t_ = threadIdx.x; asm volatile("" : "+v"(t_)); F.tid = t_; F.lane = t_ & 63; } while (0)

#ifndef PHMASK
#define PHMASK 0xFFFF
#endif
    if constexpr ((PHMASK & 1) != 0) prologue(F, A);
    GRID_BAR();
    if constexpr ((PHMASK & 2) != 0) rowpass_first(F, A);
    GRID_BAR();

    const float* MOD = (const float*)(F.ws + WS_MOD);
#pragma unroll 1
    for (int l = 0; l < DEPTH; ++l) {
        unsigned char* wl = F.ws + WS_W + (size_t)l * W_LAYER; const float* modl = MOD + (size_t)l * 5 * NMOD;
        if constexpr ((PHMASK & 4) != 0) {
            pg8::Gemm g{(const bf16*)(F.ws + WS_HA), (const bf16*)(wl + WO_IN), T, NIN, D}; pg8::StaticOrder S; S.init(T, NIN, F.G, (int)blockIdx.x);
            EpiIn E{(bf16*)(F.ws + WS_Q), (bf16*)(F.ws + WS_KC), (bf16*)(F.ws + WS_VTC), (bf16*)(F.ws + WS_KL + (size_t)l * KL_LAYER), (bf16*)(F.ws + WS_VTL + (size_t)l * KL_LAYER),
                    (bf16*)(F.ws + WS_P), (bf16*)(F.ws + WS_G), F.out + OUT_NK, F.out + OUT_NV, A.in[9] + l * 64, A.in[10] + l * 64,
                    (const float*)(F.ws + WS_ROPE), (const float*)(F.ws + WS_ROPE) + 1024 * 32, l};
            pg8::gemm_phase<EpiIn, pg8::StaticOrder, true, true>(F.lds, g, S, E);
        }
        GRID_BAR();
        if constexpr ((PHMASK & 8) != 0) mix_phase(F, A, l);
        GRID_BAR();
        if constexpr ((PHMASK & 16) != 0) {
            pg8::Gemm g{(const bf16*)(F.ws + WS_AP), (const bf16*)(wl + WO_UP2), T, D, D}; pg8::StaticOrder S; S.init(T, D, F.G, (int)blockIdx.x);
            EpiUp E{(const bf16*)(F.ws + WS_G), (bf16*)(F.ws + WS_MIX)};
            pg8::gemm_phase<EpiUp, pg8::StaticOrder, true, true>(F.lds, g, S, E);
        }
        GRID_BAR();
        if constexpr ((PHMASK & 32) != 0) {
            pg8::Gemm g{(const bf16*)(F.ws + WS_MIX), (const bf16*)(wl + WO_OUT), T, D, D}; pg8::StaticOrder S; S.init(T, D, F.G, (int)blockIdx.x);
            EpiF32 E{(float*)(F.ws + WS_MO)};
            pg8::gemm_phase<EpiF32, pg8::StaticOrder, true, true>(F.lds, g, S, E);
        }
        GRID_BAR();
        if constexpr ((PHMASK & 64) != 0) rowpass(F, A, l == 0, A.in[17] + (size_t)l * D, modl, 2 * D, A.in[18] + (size_t)l * D, modl, 4 * D, 3 * D);
        GRID_BAR();
        if constexpr ((PHMASK & 128) != 0) {
            pg8::Gemm g{(const bf16*)(F.ws + WS_HA), (const bf16*)(wl + WO_GU), T, 2 * FF, D}; pg8::StaticOrder S; S.init(T, 2 * FF, F.G, (int)blockIdx.x);
            EpiGU E{(bf16*)(F.ws + WS_HID)};
            pg8::gemm_phase<EpiGU, pg8::StaticOrder, true, true>(F.lds, g, S, E);
        }
        GRID_BAR();
        if constexpr ((PHMASK & 256) != 0) {
            pg8::Gemm g{(const bf16*)(F.ws + WS_HID), (const bf16*)(wl + WO_DN), T, D, FF}; pg8::StaticOrder S; S.init(T, D, F.G, (int)blockIdx.x);
            EpiF32 E{(float*)(F.ws + WS_MO)};
            pg8::gemm_phase<EpiF32, pg8::StaticOrder, true, true>(F.lds, g, S, E);
        }
        GRID_BAR();
        if constexpr ((PHMASK & 512) != 0) { if (l + 1 < DEPTH) rowpass(F, A, false, A.in[19] + (size_t)l * D, modl, 5 * D, A.in[16] + (size_t)(l + 1) * D, modl + 5 * NMOD, 1 * D, 0);
        else rowpass(F, A, false, A.in[19] + (size_t)l * D, modl, 5 * D, nullptr, modl, 0, 0); }
        if (l + 1 < DEPTH) GRID_BAR();
    }
}

extern "C" void kernel_launch(void* const* d_in, const int* in_sizes, int n_in, void* d_out, int out_size, void* d_ws, size_t ws_size, hipStream_t stream) {
    static int grid = 0;
    if (grid == 0) {
        if (n_in != 23 || out_size != (int)(OUT_NV + (size_t)32 * 4 * 256 * 128) || ws_size < WS_END) {
            fprintf(stderr, "kernel_launch: unexpected shapes (n_in %d, out %d, ws %zu); nothing launched\n", n_in, out_size, ws_size); grid = -1; return; }
        int dev = 0, cus = 0, per_cu = 0;
        if (hipGetDevice(&dev) != hipSuccess || hipDeviceGetAttribute(&cus, hipDeviceAttributeMultiprocessorCount, dev) != hipSuccess) { grid = -1; return; }
        if (hipFuncSetAttribute((const void*)fwd_kernel, hipFuncAttributeMaxDynamicSharedMemorySize, LDS_BYTES) != hipSuccess) { fprintf(stderr, "kernel_launch: hipFuncSetAttribute failed\n"); grid = -1; return; }
        if (hipOccupancyMaxActiveBlocksPerMultiprocessor(&per_cu, (const void*)fwd_kernel, NWAVES * 64, LDS_BYTES) != hipSuccess || per_cu < 1) { fprintf(stderr, "kernel_launch: note: occupancy query says %d blocks per CU; launching one per CU anyway\n", per_cu); (void)hipGetLastError(); }
        grid = cus;
    }
    if (grid < 0) return;
    (void)hipMemsetAsync((char*)d_ws + WS_CTL, 0, CTL_ZERO_BYTES, stream);
    Args a{};
    for (int i = 0; i < 23; ++i) a.in[i] = (const float*)d_in[i];
    a.out = (float*)d_out; a.ws = (unsigned char*)d_ws;
    void* kargs[] = {&a};
    hipError_t e = hipLaunchCooperativeKernel((const void*)fwd_kernel, dim3(grid), dim3(NWAVES * 64), kargs, LDS_BYTES, stream);
    if (e != hipSuccess) fprintf(stderr, "kernel_launch: cooperative launch failed: %s (grid %d)\n", hipGetErrorString(e), grid);
}
```

```cpp
#include <hip/hip_runtime.h>
#include <cstdio>
#include <cstdint>
namespace pg8 {
#define PG8_LAS __attribute__((address_space(3)))
typedef unsigned short bf16_t;
typedef short bf16x8 __attribute__((ext_vector_type(8)));
typedef float f32x4 __attribute__((ext_vector_type(4)));
typedef unsigned u32x4 __attribute__((ext_vector_type(4)));
constexpr int BM = 256, BK = 64, HALF = 128, HTB = HALF * BK * 2  , STAGE_BYTES = 8 * HTB, NXCD = 8, WGM = 8;

__host__ __device__ __forceinline__ int lds_byte(int r, int c) { const int st = (r >> 4) * 2 + (c >> 5), rr = r & 15, cc = c & 31, ob = rr * 64 + cc * 2; return st * 1024 + (ob ^ (((ob >> 9) & 1) << 5)); }
__host__ __device__ __forceinline__ void stage_rc(int b, int& R, int& C) { const int st = b / 1024, sb = b % 1024, swz = sb ^ (((sb >> 9) & 1) << 5); R = (st >> 1) * 16 + swz / 64; C = (st & 1) * 32 + (swz % 64) / 2; }
__host__ __device__ __forceinline__ int perm32(int rho) { const int n = rho >> 4, i = rho & 15; return 8 * (i >> 2) + 4 * n + (i & 3); }

struct Unit { int pm, pn; };
struct Gemm { const bf16_t* A; const bf16_t* Bt; int M, N, K; };

struct StaticOrder {
    int nM, nN, nwg, G, c;
    __host__ __device__ void init(int M, int N, int G_, int c_) { nM = M / BM; nN = N / BM; nwg = nM * nN; G = G_; c = c_; }
    __host__ __device__ bool next(int i, Unit& u) const {
        const long L = (long)i * G + c; if (L >= nwg) return false;
        int wgid = (int)L; { const int q = nwg / NXCD, r = nwg % NXCD, xcd = wgid % NXCD, off = wgid / NXCD; wgid = (xcd < r ? xcd * (q + 1) : r * (q + 1) + (xcd - r) * q) + off; }
        const int nig = WGM * nN, gid = wgid / nig, fm = gid * WGM, gsz = (nM - fm) < WGM ? (nM - fm) : WGM;
        u.pm = fm + ((wgid % nig) % gsz); u.pn = (wgid % nig) / gsz; return true;
    }
    __device__ __forceinline__ void a_ready(const Unit&) const {}
    __device__ __forceinline__ void done(const Unit&) const {}
};
__device__ __forceinline__ unsigned cvt_pk_bf16(float lo, float hi) { unsigned r; asm volatile("v_cvt_pk_bf16_f32 %0, %1, %2" : "=v"(r) : "v"(lo), "v"(hi)); return r; }
typedef float f32x2 __attribute__((ext_vector_type(2)));
template <class Epi, class Sched, bool ALIGN_EPI = false, bool SP2 = false>
__device__ __forceinline__ void gemm_phase(PG8_LAS unsigned char* lds, const Gemm g, const Sched& S, const Epi& E) {
    int tid_ = threadIdx.x; asm volatile("" : "+v"(tid_));
    const int tid = tid_, wid = __builtin_amdgcn_readfirstlane(tid >> 6), lane = tid & 63, wr = wid >> 2, wc = wid & 3, fr = lane & 15, fq = lane >> 4;
    const int K = g.K, nt = K / BK;
    unsigned voffA[2], voffB[2];
#pragma unroll
    for (int i = 0; i < 2; ++i) { int R, C; stage_rc(tid * 16 + i * 8192, R, C); const int Rin = Epi::PERM ? perm32(R & 31) : (R & 31); const int Rb = Epi::NMAP64 ? (64 * (R >> 5) + Rin) : ((R & ~31) + Rin);
        voffA[i] = (unsigned)(R * K + C) * 2u; voffB[i] = (unsigned)(Rb * K + C) * 2u; }
    const size_t kstep = (size_t)(BK * 2);
    const size_t hstep = (size_t)HALF * K * 2;
    const size_t hstepB = Epi::NMAP64 ? (size_t)32 * K * 2 : hstep;
    const size_t tstep = 2 * hstep;
    const unsigned ldsw = (unsigned)wid * 1024u;
    const int aoff = lds_byte(wr * 64 + fr, fq * 8), boff = lds_byte(wc * 32 + fr, fq * 8);
#define PG8_SA(b, h) (((b) * 2 + (h)) * HTB)
#define PG8_SB(b, h) ((4 + (b) * 2 + (h)) * HTB)
#define PG8_STAGE(bufoff, gbase, voff) do { _Pragma("unroll") for (int _i = 0; _i < 2; ++_i) \
        __builtin_amdgcn_global_load_lds((const unsigned*)((const char*)(gbase) + (voff)[_i]), (PG8_LAS unsigned*)(lds + (bufoff) + ldsw + _i * 8192), 16, 0, 0); } while (0)
#define PG8_LDA(dst, b, h) do { _Pragma("unroll") for (int m = 0; m < 4; ++m) _Pragma("unroll") for (int k = 0; k < 2; ++k) dst[m][k] = *(const PG8_LAS bf16x8*)(lds + PG8_SA(b, h) + aoff + m * 2048 + k * 1024); } while (0)
#define PG8_LDB(dst, b, h) do { _Pragma("unroll") for (int n = 0; n < 2; ++n) _Pragma("unroll") for (int k = 0; k < 2; ++k) dst[n][k] = *(const PG8_LAS bf16x8*)(lds + PG8_SB(b, h) + boff + n * 2048 + k * 1024); } while (0)
#define PG8_MMA(ai, bj, At, Bt) do { __builtin_amdgcn_s_setprio(1); _Pragma("unroll") for (int m = 0; m < 4; ++m) _Pragma("unroll") for (int n = 0; n < 2; ++n) _Pragma("unroll") for (int k = 0; k < 2; ++k) \
        acc[ai][bj][m][n] = __builtin_amdgcn_mfma_f32_16x16x32_bf16(Bt[n][k], At[m][k], acc[ai][bj][m][n], 0, 0, 0); __builtin_amdgcn_s_setprio(0); } while (0)
#define PG8_WAIT_V(n) asm volatile("s_waitcnt vmcnt(" #n ")" ::: "memory")
#define PG8_WAIT_L(n) asm volatile("s_waitcnt lgkmcnt(" #n ")" ::: "memory")
#define PG8_BAR __builtin_amdgcn_s_barrier()
#define PG8_SCHED __builtin_amdgcn_sched_barrier(0)
    Unit cur, nxt; int ui = 0;
    if (!S.next(0, cur)) return;
    f32x4 acc[2][2][4][2];
#pragma unroll
    for (int a = 0; a < 2; ++a)
#pragma unroll
        for (int b = 0; b < 2; ++b)
#pragma unroll
            for (int m = 0; m < 4; ++m)
#pragma unroll
                for (int n = 0; n < 2; ++n) acc[a][b][m][n] = (f32x4){0.f, 0.f, 0.f, 0.f};
    bf16x8 At[4][2], B0[2][2], B1[2][2];
    const char* cA = (const char*)g.A + (size_t)cur.pm * tstep; const char* cB = (const char*)g.Bt + (size_t)cur.pn * tstep;
    S.a_ready(cur);
    if constexpr (SP2) {
        PG8_STAGE(PG8_SB(0, 0), cB, voffB); PG8_STAGE(PG8_SB(0, 1), cB + hstepB, voffB); PG8_STAGE(PG8_SA(0, 0), cA, voffA); PG8_STAGE(PG8_SA(0, 1), cA + hstep, voffA);
        if (wr == 1) PG8_BAR;
        PG8_WAIT_V(2); PG8_BAR;
        PG8_STAGE(PG8_SB(1, 0), cB + kstep, voffB); PG8_STAGE(PG8_SA(1, 0), cA + kstep, voffA); PG8_STAGE(PG8_SB(1, 1), cB + hstepB + kstep, voffB);
        PG8_WAIT_V(6); PG8_BAR;
    } else {
        PG8_STAGE(PG8_SB(0, 0), cB, voffB); PG8_STAGE(PG8_SA(0, 0), cA, voffA); PG8_STAGE(PG8_SB(0, 1), cB + hstepB, voffB); PG8_STAGE(PG8_SA(0, 1), cA + hstep, voffA);
        if (wr == 1) PG8_BAR;
        PG8_WAIT_V(4); PG8_BAR;
        PG8_STAGE(PG8_SB(1, 0), cB + kstep, voffB); PG8_STAGE(PG8_SA(1, 0), cA + kstep, voffA); PG8_STAGE(PG8_SB(1, 1), cB + hstepB + kstep, voffB);
        PG8_WAIT_V(6); PG8_BAR;
    }
    for (;;) {
        const bool has_next = S.next(ui + 1, nxt);
        const char* nA = has_next ? (const char*)g.A + (size_t)nxt.pm * tstep : cA; const char* nB = has_next ? (const char*)g.Bt + (size_t)nxt.pn * tstep : cB;
        for (int t = 0; t < nt; t += 2) {
            const bool last = (t == nt - 2);
            if constexpr (Epi::HAS_MID) { if (t == (nt >> 1)) E.mid(acc, cur, wr, wc, fr, fq); }
            const char* a1 = cA + (size_t)(t + 1) * kstep;
            const char* a2 = last ? nA : cA + (size_t)(t + 2) * kstep; const char* b2 = last ? nB : cB + (size_t)(t + 2) * kstep;
            const char* a3 = a2 + kstep; const char* b3 = b2 + kstep;
            if (last && has_next) S.a_ready(nxt);
            if constexpr (SP2) {
            PG8_LDB(B0, 0, 0); PG8_LDB(B1, 0, 1); PG8_SCHED; PG8_LDA(At, 0, 0); PG8_STAGE(PG8_SA(1, 1), a1 + hstep, voffA);
            PG8_WAIT_V(8); PG8_WAIT_L(0); PG8_BAR; PG8_MMA(0, 0, At, B0); PG8_MMA(0, 1, At, B1); PG8_BAR; PG8_SCHED;
            PG8_LDA(At, 0, 1); PG8_STAGE(PG8_SB(0, 0), b2, voffB); PG8_STAGE(PG8_SB(0, 1), b2 + hstepB, voffB); PG8_STAGE(PG8_SA(0, 0), a2, voffA);
            PG8_WAIT_V(8); PG8_WAIT_L(0); PG8_BAR; PG8_MMA(1, 0, At, B0); PG8_MMA(1, 1, At, B1); PG8_BAR; PG8_SCHED;
            PG8_LDB(B0, 1, 0); PG8_LDB(B1, 1, 1); PG8_SCHED; PG8_LDA(At, 1, 0); PG8_STAGE(PG8_SA(0, 1), a2 + hstep, voffA);
            PG8_WAIT_V(8); PG8_WAIT_L(0); PG8_BAR; PG8_MMA(0, 0, At, B0); PG8_MMA(0, 1, At, B1); PG8_BAR; PG8_SCHED;
            PG8_LDA(At, 1, 1); PG8_STAGE(PG8_SB(1, 0), b3, voffB); PG8_STAGE(PG8_SB(1, 1), b3 + hstepB, voffB); PG8_STAGE(PG8_SA(1, 0), a3, voffA);
            PG8_WAIT_V(8); PG8_WAIT_L(0); PG8_BAR; PG8_MMA(1, 0, At, B0); PG8_MMA(1, 1, At, B1); PG8_BAR; PG8_SCHED;
            } else {
            PG8_LDB(B0, 0, 0); PG8_SCHED; PG8_LDA(At, 0, 0); PG8_STAGE(PG8_SA(1, 1), a1 + hstep, voffA);
            PG8_WAIT_L(8); PG8_BAR; PG8_WAIT_L(0); PG8_MMA(0, 0, At, B0); PG8_BAR; PG8_SCHED;
            PG8_LDB(B1, 0, 1); PG8_STAGE(PG8_SB(0, 0), b2, voffB);
            PG8_BAR; PG8_WAIT_L(0); PG8_MMA(0, 1, At, B1); PG8_BAR;
            PG8_LDA(At, 0, 1); PG8_STAGE(PG8_SA(0, 0), a2, voffA);
            PG8_BAR; PG8_WAIT_L(0); PG8_MMA(1, 0, At, B0); PG8_BAR; PG8_SCHED;
            PG8_STAGE(PG8_SB(0, 1), b2 + hstepB, voffB);
            PG8_WAIT_V(6); PG8_BAR; PG8_MMA(1, 1, At, B1); PG8_BAR;
            PG8_LDB(B0, 1, 0); PG8_SCHED; PG8_LDA(At, 1, 0); PG8_STAGE(PG8_SA(0, 1), a2 + hstep, voffA);
            PG8_WAIT_L(8); PG8_BAR; PG8_WAIT_L(0); PG8_MMA(0, 0, At, B0); PG8_BAR; PG8_SCHED;
            PG8_LDB(B1, 1, 1); PG8_STAGE(PG8_SB(1, 0), b3, voffB);
            PG8_BAR; PG8_WAIT_L(0); PG8_MMA(0, 1, At, B1); PG8_BAR;
            PG8_LDA(At, 1, 1); PG8_STAGE(PG8_SA(1, 0), a3, voffA);
            PG8_BAR; PG8_WAIT_L(0); PG8_MMA(1, 0, At, B0); PG8_BAR; PG8_SCHED;
            PG8_STAGE(PG8_SB(1, 1), b3 + hstepB, voffB);
            PG8_WAIT_V(6); PG8_BAR; PG8_MMA(1, 1, At, B1); PG8_BAR;
            }
        }
        if constexpr (ALIGN_EPI) { if (wr == 0) PG8_BAR; }
        if constexpr (!Epi::AFTER_DRAIN) { E(acc, cur, wr, wc, fr, fq); S.done(cur); }
        if (!has_next) break;
#pragma unroll
        for (int a = 0; a < 2; ++a)
#pragma unroll
            for (int b = 0; b < 2; ++b)
#pragma unroll
                for (int m = 0; m < 4; ++m)
#pragma unroll
                    for (int n = 0; n < 2; ++n) acc[a][b][m][n] = (f32x4){0.f, 0.f, 0.f, 0.f};
        cur = nxt; cA = nA; cB = nB; ++ui;
        if constexpr (ALIGN_EPI) { if (wr == 1) PG8_BAR; }
    }
    PG8_WAIT_V(0);
    if constexpr (!ALIGN_EPI) { if (wr == 0) PG8_BAR; }
    PG8_BAR;
    if constexpr (Epi::AFTER_DRAIN) { E.fused(acc, cur, wr, wc, fr, fq, lds, wid, lane); S.done(cur); }
#undef PG8_SA
#undef PG8_SB
#undef PG8_STAGE
#undef PG8_LDA
#undef PG8_LDB
#undef PG8_MMA
#undef PG8_WAIT_V
#undef PG8_WAIT_L
#undef PG8_BAR
#undef PG8_SCHED
}
}

constexpr int NWAVES = 8;
constexpr int D = 1024, TC = 8192, TL = 4096, T = TC + TL, DEPTH = 4, NIN = 3328, FF = 2816, NMOD = 6 * D;
constexpr int LKEYS = 1280;
constexpr float EPS = 1e-6f;
constexpr float QSCALE = 0.125f * 1.4426950408889634f;
constexpr size_t OUT_Y = 0, OUT_NK = (size_t)T * D, OUT_NV = OUT_NK + (size_t)32 * 4 * 256 * 128;

constexpr size_t MiB = 1u << 20;
constexpr size_t WS_CTL = 0, CTL_ZERO_BYTES = 1 * MiB;
constexpr int CW_BAR = 4096;
constexpr size_t WS_MOD = 512 * 1024;
constexpr size_t WS_ROPE = 1 * MiB;
constexpr size_t WS_W = 2 * MiB, W_LAYER = 28 * MiB;
constexpr size_t WO_IN = 0, WO_UP2 = 6815744, WO_OUT = WO_UP2 + 2 * MiB, WO_GU = WO_OUT + 2 * MiB, WO_DN = WO_GU + 11534336, WO_PT = WO_DN + 5767168;
static_assert(WO_PT + 131072 <= W_LAYER, "weights per layer");
constexpr size_t WS_KL = 114 * MiB, KL_LAYER = (size_t)4 * LKEYS * 128 * 2;
constexpr size_t WS_VTL = 119 * MiB;
constexpr size_t WS_KC = 124 * MiB, WS_VTC = 126 * MiB;
constexpr size_t WS_HA = 128 * MiB, WS_AP = 152 * MiB, WS_MIX = 176 * MiB, WS_MO = 200 * MiB, WS_G = 248 * MiB, WS_Q = 296 * MiB, WS_P = 308 * MiB, WS_HID = 248 * MiB, WS_END = 320 * MiB;
static_assert(WS_W + DEPTH * W_LAYER <= WS_KL && WS_KL + DEPTH * KL_LAYER <= WS_VTL && WS_VTL + DEPTH * KL_LAYER <= WS_KC, "ws map");
static_assert(WS_HID + (size_t)T * FF * 2 <= WS_END, "hid overlay");

constexpr int RING_BYTES = 131072, LDSCTL_OFF = RING_BYTES, MISC_OFF = LDSCTL_OFF + 320, LDS_BYTES = 147456;

#define GAS __attribute__((address_space(1)))
#define LAS __attribute__((address_space(3)))
typedef unsigned short bf16;
typedef unsigned v4u __attribute__((ext_vector_type(4)));
typedef unsigned v2u __attribute__((ext_vector_type(2)));
typedef float f32x4 __attribute__((ext_vector_type(4)));
typedef float f32x16 __attribute__((ext_vector_type(16)));
typedef short bf16x8 __attribute__((ext_vector_type(8)));
typedef GAS unsigned gu32;
#define RLX_AGENT __ATOMIC_RELAXED, __HIP_MEMORY_SCOPE_AGENT
#define LDS_WAIT() asm volatile("s_waitcnt lgkmcnt(0)" ::: "memory")

__device__ __forceinline__ unsigned cvtpk(float lo, float hi) { unsigned r; asm volatile("v_cvt_pk_bf16_f32 %0, %1, %2" : "=v"(r) : "v"(lo), "v"(hi)); return r; }
__device__ __forceinline__ float bflo(unsigned u) { return __uint_as_float(u << 16); }
__device__ __forceinline__ float bfhi(unsigned u) { return __uint_as_float(u & 0xffff0000u); }
__device__ __forceinline__ float fast_sigmoid(float x) { return __builtin_amdgcn_rcpf(1.0f + __builtin_amdgcn_exp2f(-1.4426950408889634f * x)); }
__device__ __forceinline__ float wave_sum(float v) {
#pragma unroll
    for (int o = 1; o < 64; o <<= 1) v += __shfl_xor(v, o);
    return v;
}
__device__ __forceinline__ int swap23(int k) { return (k & ~12) | ((k & 4) << 1) | ((k & 8) >> 1); }
__device__ __forceinline__ int mod_index(int row) { return row < TC ? 0 : 1 + ((row - TC) >> 10); }


struct EpiIn {
    static constexpr bool PERM = true, AFTER_DRAIN = false, NMAP64 = true, HAS_MID = false;
    bf16 *Q, *KC, *VTC, *KL, *VTL, *P, *G; float *nk, *nv; const float *qn, *kn, *rc, *rs; int layer;
    __device__ __forceinline__ void mid(f32x4 (&)[2][2][4][2], const pg8::Unit&, int, int, int, int) const {}
    __device__ __forceinline__ void operator()(const f32x4 (&acc)[2][2][4][2], const pg8::Unit& u, int wr, int wc, int fr, int fq) const {
        asm volatile("" : "+v"(fr), "+v"(fq));
        const int pn = u.pn; const int rowb = u.pm * 256 + wr * 64 + fr; const bool ctx = u.pm < 32;
        if (pn >= 3) {
            const bool gate = pn >= 5; bf16* dst = gate ? G : P; const int ld = gate ? 2048 : 512; const int col0 = (gate ? (pn - 5) : (pn - 3)) * 256 + wc * 64 + 8 * fq;
#pragma unroll
            for (int ai = 0; ai < 2; ++ai)
#pragma unroll
                for (int m = 0; m < 4; ++m) { const int row = rowb + ai * 128 + m * 16;
#pragma unroll
                    for (int bj = 0; bj < 2; ++bj) { f32x4 v0 = acc[ai][bj][m][0], v1 = acc[ai][bj][m][1];
                        if (gate) {
#pragma unroll
                            for (int e = 0; e < 4; ++e) { v0[e] = fast_sigmoid(v0[e]); v1[e] = fast_sigmoid(v1[e]); } }
                        v4u w; w.x = cvtpk(v0[0], v0[1]); w.y = cvtpk(v0[2], v0[3]); w.z = cvtpk(v1[0], v1[1]); w.w = cvtpk(v1[2], v1[3]);
                        *(GAS v4u*)(dst + (size_t)row * ld + col0 + 32 * bj) = w; } asm volatile("" ::: "memory"); }
        } else if (pn == 2 && wc >= 2) {
            const int kvh = wc - 2;
#pragma unroll
            for (int ai = 0; ai < 2; ++ai)
#pragma unroll
                for (int m = 0; m < 4; ++m) { const int row = rowb + ai * 128 + m * 16;
                    bf16* vt; int vld;
                    if (ctx) { const int b = row >> 8, s = row & 255; float* o = nv + ((size_t)((b * 4 + layer) * 256 + s)) * 128 + kvh * 64 + 8 * fq;
#pragma unroll
                        for (int bj = 0; bj < 2; ++bj) { *(GAS f32x4*)(o + 32 * bj) = acc[ai][bj][m][0]; *(GAS f32x4*)(o + 32 * bj + 4) = acc[ai][bj][m][1]; }
                        vt = VTC + (size_t)((b * 2 + kvh) * 64) * 256 + ((s & ~15) | swap23(s & 15)); vld = 256;
                    } else { const int b = (row - TC) >> 10, s = (row - TC) & 1023;
                        vt = VTL + (size_t)((b * 2 + kvh) * 64) * LKEYS + 256 + ((s & ~15) | swap23(s & 15)); vld = LKEYS; }
#pragma unroll
                    for (int bj = 0; bj < 2; ++bj)
#pragma unroll
                        for (int n = 0; n < 2; ++n) { const f32x4 v = acc[ai][bj][m][n]; const unsigned p0 = cvtpk(v[0], v[1]), p1 = cvtpk(v[2], v[3]); const int d = 32 * bj + 8 * fq + 4 * n;
                            *(GAS bf16*)(vt + (size_t)(d + 0) * vld) = (bf16)(p0 & 0xffffu); *(GAS bf16*)(vt + (size_t)(d + 1) * vld) = (bf16)(p0 >> 16);
                            *(GAS bf16*)(vt + (size_t)(d + 2) * vld) = (bf16)(p1 & 0xffffu); *(GAS bf16*)(vt + (size_t)(d + 3) * vld) = (bf16)(p1 >> 16); } asm volatile("" ::: "memory"); }
        } else {
            const bool isq = pn < 2; const float* w = isq ? qn : kn; const int head = isq ? 4 * pn + wc : wc;
            const f32x4 w00 = *(const GAS f32x4*)(w + 8 * fq), w01 = *(const GAS f32x4*)(w + 8 * fq + 4), w10 = *(const GAS f32x4*)(w + 32 + 8 * fq), w11 = *(const GAS f32x4*)(w + 36 + 8 * fq);
#pragma unroll
            for (int ai = 0; ai < 2; ++ai)
#pragma unroll
                for (int m = 0; m < 4; ++m) { const int row = rowb + ai * 128 + m * 16;
                    f32x4 a0 = acc[ai][0][m][0], a1 = acc[ai][0][m][1], b0 = acc[ai][1][m][0], b1 = acc[ai][1][m][1];
                    float ss = (a0[0] * a0[0] + a0[1] * a0[1]) + (a0[2] * a0[2] + a0[3] * a0[3]) + (a1[0] * a1[0] + a1[1] * a1[1]) + (a1[2] * a1[2] + a1[3] * a1[3])
                             + (b0[0] * b0[0] + b0[1] * b0[1]) + (b0[2] * b0[2] + b0[3] * b0[3]) + (b1[0] * b1[0] + b1[1] * b1[1]) + (b1[2] * b1[2] + b1[3] * b1[3]);
                    ss += __shfl_xor(ss, 16); ss += __shfl_xor(ss, 32);
                    const float r = 1.0f / sqrtf(ss * (1.0f / 64.0f) + EPS);
                    a0 = a0 * r * w00; a1 = a1 * r * w01; b0 = b0 * r * w10; b1 = b1 * r * w11;
                    if (!ctx) { const int s = (row - TC) & 1023;
                        const f32x4 c0 = *(const GAS f32x4*)(rc + s * 32 + 8 * fq), c1 = *(const GAS f32x4*)(rc + s * 32 + 8 * fq + 4), s0 = *(const GAS f32x4*)(rs + s * 32 + 8 * fq), s1 = *(const GAS f32x4*)(rs + s * 32 + 8 * fq + 4);
                        const f32x4 na0 = a0 * c0 - b0 * s0, nb0 = b0 * c0 + a0 * s0, na1 = a1 * c1 - b1 * s1, nb1 = b1 * c1 + a1 * s1; a0 = na0; b0 = nb0; a1 = na1; b1 = nb1; }
                    if (isq) { a0 = a0 * QSCALE; a1 = a1 * QSCALE; b0 = b0 * QSCALE; b1 = b1 * QSCALE; }
                    else if (ctx) { const int b = row >> 8, s = row & 255; float* o = nk + ((size_t)((b * 4 + layer) * 256 + s)) * 128 + head * 64 + 8 * fq;
                        *(GAS f32x4*)(o) = a0; *(GAS f32x4*)(o + 4) = a1; *(GAS f32x4*)(o + 32) = b0; *(GAS f32x4*)(o + 36) = b1; }
                    bf16* dst;
                    if (isq) dst = Q + (size_t)row * 512 + head * 64 + 8 * fq;
                    else if (ctx) dst = KC + (size_t)row * 128 + head * 64 + 8 * fq;
                    else { const int b = (row - TC) >> 10, s = (row - TC) & 1023; dst = KL + (size_t)(b * LKEYS + 256 + s) * 128 + head * 64 + 8 * fq; }
                    v4u wa, wb; wa.x = cvtpk(a0[0], a0[1]); wa.y = cvtpk(a0[2], a0[3]); wa.z = cvtpk(a1[0], a1[1]); wa.w = cvtpk(a1[2], a1[3]);
                    wb.x = cvtpk(b0[0], b0[1]); wb.y = cvtpk(b0[2], b0[3]); wb.z = cvtpk(b1[0], b1[1]); wb.w = cvtpk(b1[2], b1[3]);
                    *(GAS v4u*)(dst) = wa; *(GAS v4u*)(dst + 32) = wb; asm volatile("" ::: "memory"); }
        }
    }
};

struct EpiUp {
    static constexpr bool PERM = true, AFTER_DRAIN = false, NMAP64 = false, HAS_MID = true;
    const bf16* G; bf16* MIX;
    __device__ __forceinline__ void mid(f32x4 (&acc)[2][2][4][2], const pg8::Unit& u, int wr, int wc, int fr, int fq) const {
        asm volatile("" : "+v"(fr), "+v"(fq));
        const int rowb = u.pm * 256 + wr * 64 + fr, colb = u.pn * 256 + wc * 32 + 8 * fq;
#pragma unroll
        for (int ai = 0; ai < 2; ++ai)
#pragma unroll
            for (int m = 0; m < 4; ++m) { const bf16* gr = G + (size_t)(rowb + ai * 128 + m * 16) * 2048 + colb;
#pragma unroll
                for (int bj = 0; bj < 2; ++bj) { const v4u ga = *(const GAS v4u*)(gr + 128 * bj), gp = *(const GAS v4u*)(gr + 1024 + 128 * bj);
                    f32x4 r0, r1;
                    r0[0] = bflo(ga.x) * __builtin_amdgcn_rcpf(bflo(gp.x)); r0[1] = bfhi(ga.x) * __builtin_amdgcn_rcpf(bfhi(gp.x)); r0[2] = bflo(ga.y) * __builtin_amdgcn_rcpf(bflo(gp.y)); r0[3] = bfhi(ga.y) * __builtin_amdgcn_rcpf(bfhi(gp.y));
                    r1[0] = bflo(ga.z) * __builtin_amdgcn_rcpf(bflo(gp.z)); r1[1] = bfhi(ga.z) * __builtin_amdgcn_rcpf(bfhi(gp.z)); r1[2] = bflo(ga.w) * __builtin_amdgcn_rcpf(bflo(gp.w)); r1[3] = bfhi(ga.w) * __builtin_amdgcn_rcpf(bfhi(gp.w));
                    acc[ai][bj][m][0] = acc[ai][bj][m][0] * r0; acc[ai][bj][m][1] = acc[ai][bj][m][1] * r1; } asm volatile("" ::: "memory"); }
        asm volatile("s_waitcnt vmcnt(0)" ::: "memory"); __builtin_amdgcn_sched_barrier(0);
    }
    __device__ __forceinline__ void operator()(const f32x4 (&acc)[2][2][4][2], const pg8::Unit& u, int wr, int wc, int fr, int fq) const {
        asm volatile("" : "+v"(fr), "+v"(fq));
        const int rowb = u.pm * 256 + wr * 64 + fr, colb = u.pn * 256 + wc * 32 + 8 * fq;
#pragma unroll
        for (int ai = 0; ai < 2; ++ai)
#pragma unroll
            for (int m = 0; m < 4; ++m) { const int row = rowb + ai * 128 + m * 16; const bf16* gr = G + (size_t)row * 2048 + 1024 + colb;
#pragma unroll
                for (int bj = 0; bj < 2; ++bj) { const v4u gp = *(const GAS v4u*)(gr + 128 * bj); const f32x4 v0 = acc[ai][bj][m][0], v1 = acc[ai][bj][m][1];
                    v4u w; w.x = cvtpk(v0[0] * bflo(gp.x), v0[1] * bfhi(gp.x)); w.y = cvtpk(v0[2] * bflo(gp.y), v0[3] * bfhi(gp.y));
                    w.z = cvtpk(v1[0] * bflo(gp.z), v1[1] * bfhi(gp.z)); w.w = cvtpk(v1[2] * bflo(gp.w), v1[3] * bfhi(gp.w));
                    *(GAS v4u*)(MIX + (size_t)row * 1024 + colb + 128 * bj) = w; } asm volatile("" ::: "memory"); }
    }
};

struct EpiGU {
    static constexpr bool PERM = true, AFTER_DRAIN = false, NMAP64 = false, HAS_MID = false;
    bf16* HID;
    __device__ __forceinline__ void mid(f32x4 (&)[2][2][4][2], const pg8::Unit&, int, int, int, int) const {}
    __device__ __forceinline__ void operator()(const f32x4 (&acc)[2][2][4][2], const pg8::Unit& u, int wr, int wc, int fr, int fq) const {
        asm volatile("" : "+v"(fr), "+v"(fq));
        const int rowb = u.pm * 256 + wr * 64 + fr, col = u.pn * 128 + wc * 32 + 8 * fq;
#pragma unroll
        for (int ai = 0; ai < 2; ++ai)
#pragma unroll
            for (int m = 0; m < 4; ++m) { const int row = rowb + ai * 128 + m * 16;
                const f32x4 g0 = acc[ai][0][m][0], g1 = acc[ai][0][m][1], u0 = acc[ai][1][m][0], u1 = acc[ai][1][m][1]; float h[8];
#pragma unroll
                for (int e = 0; e < 4; ++e) { h[e] = g0[e] * fast_sigmoid(g0[e]) * u0[e]; h[4 + e] = g1[e] * fast_sigmoid(g1[e]) * u1[e]; }
                v4u w; w.x = cvtpk(h[0], h[1]); w.y = cvtpk(h[2], h[3]); w.z = cvtpk(h[4], h[5]); w.w = cvtpk(h[6], h[7]);
                *(GAS v4u*)(HID + (size_t)row * FF + col) = w; }
    }
};

struct EpiF32 {
    static constexpr bool PERM = false, AFTER_DRAIN = false, NMAP64 = false, HAS_MID = false;
    float* C;
    __device__ __forceinline__ void mid(f32x4 (&)[2][2][4][2], const pg8::Unit&, int, int, int, int) const {}
    __device__ __forceinline__ void operator()(const f32x4 (&acc)[2][2][4][2], const pg8::Unit& u, int wr, int wc, int fr, int fq) const {
        asm volatile("" : "+v"(fr), "+v"(fq));
        const int row0 = u.pm * 256 + wr * 64 + fr, col0 = u.pn * 256 + wc * 32 + 4 * fq;
#pragma unroll
        for (int ai = 0; ai < 2; ++ai)
#pragma unroll
            for (int m = 0; m < 4; ++m) { float* rowp = C + (size_t)(row0 + ai * 128 + m * 16) * D + col0;
#pragma unroll
                for (int bj = 0; bj < 2; ++bj)
#pragma unroll
                    for (int n = 0; n < 2; ++n) *(GAS f32x4*)(rowp + bj * 128 + n * 16) = acc[ai][bj][m][n]; }
    }
};

#define XB_TMO      128
#define XB_XCNT(j)  (256  + 64 * (j))
#define XB_XSUB(j)  (1280 + 64 * (j))
#define XB_XGEN(j)  (2304 + 64 * (j))
#define XB_TOP      3328
#define XB_TOPGEN   3392
#define XCD_BAR_WORDS 3456
#define XB_SPIN_CAP (1u << 18)

__device__ __forceinline__ unsigned xb_ld(unsigned* p)              { return __hip_atomic_load(p, __ATOMIC_RELAXED, __HIP_MEMORY_SCOPE_AGENT); }
__device__ __forceinline__ unsigned xb_add(unsigned* p, unsigned v) { return __hip_atomic_fetch_add(p, v, __ATOMIC_RELAXED, __HIP_MEMORY_SCOPE_AGENT); }
__device__ __forceinline__ unsigned xb_xcc_id() { return (unsigned)__builtin_amdgcn_s_getreg((3 << 11) | 20) & 0xFu; }
#define XB_SPIN(cond, bar) do { unsigned _sp = 0; while (cond) { __builtin_amdgcn_s_sleep(1); \
    if ((++_sp & 255u) == 0u) { if (xb_ld(&(bar)[XB_TMO])) break; if (_sp > XB_SPIN_CAP) { atomicAdd(&(bar)[XB_TMO], 1u); break; } } } } while (0)

struct XcdBarrier {
    unsigned* bar; unsigned x;
    volatile LAS unsigned* st;
};

__device__ __forceinline__ XcdBarrier xcd_barrier_post(unsigned* bar, volatile LAS unsigned* st) {
    XcdBarrier b; b.bar = bar; b.x = xb_xcc_id(); b.st = st;
    if (threadIdx.x == 0) (void)xb_add(&bar[XB_XCNT(b.x)], 1u);
    return b;
}
__device__ __forceinline__ void xcd_barrier_complete(unsigned* bar, unsigned x, unsigned& nloc, unsigned& nx) {
    const unsigned G = gridDim.x * gridDim.y * gridDim.z;
    unsigned sum, cnt, mine, sp = 0u;
    for (;;) {
        sum = 0u; cnt = 0u; mine = 0u;
#pragma unroll
        for (unsigned j = 0; j < 16; ++j) { const unsigned c = xb_ld(&bar[XB_XCNT(j)]); sum += c; cnt += (c > 0u) ? 1u : 0u; mine = (j == x) ? c : mine; }
        if (sum == G) break;
        __builtin_amdgcn_s_sleep(1);
        if ((++sp & 255u) == 0u) { if (xb_ld(&bar[XB_TMO])) break; if (sp > XB_SPIN_CAP) { atomicAdd(&bar[XB_TMO], 1u); break; } }
    }
    nloc = mine > 0u ? mine : 1u; nx = cnt > 0u ? cnt : 1u;
}

__device__ __forceinline__ void xcd_barrier(const XcdBarrier& b) {
    asm volatile("s_waitcnt vmcnt(0)" ::: "memory");
    __syncthreads();
    if (threadIdx.x == 0) {
        unsigned* bar = b.bar;
        __builtin_amdgcn_s_waitcnt(0);
        unsigned nloc = b.st[0], nx = b.st[1];
        if (nloc == 0u) { xcd_barrier_complete(bar, b.x, nloc, nx); b.st[0] = nloc; b.st[1] = nx; }
        const unsigned old = xb_add(&bar[XB_XSUB(b.x)], 1u);
        const unsigned gen = old / nloc;
        if (old + 1u == (gen + 1u) * nloc) {
            __builtin_amdgcn_fence(__ATOMIC_RELEASE, "agent");
            asm volatile("s_waitcnt vmcnt(0)" ::: "memory");
            const unsigned og = xb_add(&bar[XB_TOP], 1u);
            const unsigned tg = og / nx;
            if (og + 1u == (tg + 1u) * nx) xb_add(&bar[XB_TOPGEN], 1u);
            else XB_SPIN(xb_ld(&bar[XB_TOPGEN]) == tg, bar);
            __builtin_amdgcn_fence(__ATOMIC_ACQUIRE, "agent");
            xb_add(&bar[XB_XGEN(b.x)], 1u);
            asm volatile("s_waitcnt vmcnt(0)" ::: "memory");
        } else {
            XB_SPIN(xb_ld(&bar[XB_XGEN(b.x)]) == gen, bar);
            __builtin_amdgcn_fence(__ATOMIC_ACQUIRE, "agent");
            asm volatile("s_waitcnt vmcnt(0)" ::: "memory");
        }
    }
    __syncthreads();
}

struct Args { const float* in[23]; float* out; unsigned char* ws; };

struct Frame {
    LAS unsigned char* lds; int tid, lane, wave, vcu, G, gw, ngw;
    float* out; unsigned char* ws;
};

__device__ __forceinline__ void transpose_item(const float* W, int N, bf16* WT, int ldd, int drow0, int dcol0, LAS float* scr, int k0, int n0, int lane) {
#pragma unroll 8
    for (int i = 0; i < 32; ++i) { const int kk = 2 * i + (lane >> 5); scr[kk * 33 + (lane & 31)] = W[(size_t)(k0 + kk) * N + n0 + (lane & 31)]; }
    LDS_WAIT(); asm volatile("" ::: "memory");
    const int c = lane & 7;
#pragma unroll
    for (int j = 0; j < 4; ++j) { const int n = (lane >> 3) + 8 * j; const LAS float* s = scr + (8 * c) * 33 + n;
        v4u o; o.x = cvtpk(s[0 * 33], s[1 * 33]); o.y = cvtpk(s[2 * 33], s[3 * 33]); o.z = cvtpk(s[4 * 33], s[5 * 33]); o.w = cvtpk(s[6 * 33], s[7 * 33]);
        *(GAS v4u*)(WT + (size_t)(drow0 + n) * ldd + dcol0 + k0 + 8 * c) = o; }
    LDS_WAIT(); asm volatile("" ::: "memory");
}

__device__ __forceinline__ float silu_f(float x) { return x / (1.0f + __expf(-x)); }

__device__ __forceinline__ void mod_item(Frame& F, const Args& A, int item) {
    typedef float f32x2 __attribute__((ext_vector_type(2)));
    const int cc = item % 48, l = item / 48; const int k0 = F.wave * 128, c0 = cc * 128 + F.lane * 2;
    float sv[2][5];
#pragma unroll
    for (int h = 0; h < 2; ++h) { sv[h][0] = silu_f(A.in[5][k0 + 64 * h + F.lane]);
#pragma unroll
        for (int b = 0; b < 4; ++b) sv[h][1 + b] = silu_f(A.in[4][b * D + k0 + 64 * h + F.lane]); }
    f32x2 acc[5];
#pragma unroll
    for (int mi = 0; mi < 5; ++mi) acc[mi] = (f32x2){0.f, 0.f};
    const float* wp = A.in[6] + ((size_t)l * D + k0) * NMOD + c0;
#pragma unroll
    for (int h = 0; h < 2; ++h)
#pragma unroll 16
        for (int kk = 0; kk < 64; ++kk) { const f32x2 w = *(const GAS f32x2*)(wp + (size_t)(64 * h + kk) * NMOD);
#pragma unroll
            for (int mi = 0; mi < 5; ++mi) { const float s = __uint_as_float(__builtin_amdgcn_readlane(__float_as_uint(sv[h][mi]), kk)); acc[mi] = acc[mi] + w * s; } }
    LAS float* part = (LAS float*)F.lds;
#pragma unroll
    for (int mi = 0; mi < 5; ++mi) *(LAS f32x2*)(part + (F.wave * 5 + mi) * 128 + F.lane * 2) = acc[mi];
    __syncthreads();
    for (int o = F.tid; o < 5 * 128; o += NWAVES * 64) { const int mi = o >> 7, c = o & 127; float s = A.in[7][(size_t)l * NMOD + cc * 128 + c];
#pragma unroll
        for (int w = 0; w < 8; ++w) s += part[(w * 5 + mi) * 128 + c];
        ((float*)(F.ws + WS_MOD))[((size_t)l * 5 + mi) * NMOD + cc * 128 + c] = s; }
    __syncthreads();
}

__device__ __forceinline__ void sincos_tab(float ang, float& sn, float& cs) {
    const double a = (double)ang; const double q = __builtin_rint(a * 0.63661977236758134308); const double r = a - q * 1.57079632679489661923; const double r2 = r * r;
    const double s = r * (1.0 + r2 * (-1.0 / 6 + r2 * (1.0 / 120 + r2 * (-1.0 / 5040 + r2 * (1.0 / 362880 + r2 * (-1.0 / 39916800 + r2 * (1.0 / 6227020800.0)))))));
    const double c = 1.0 + r2 * (-0.5 + r2 * (1.0 / 24 + r2 * (-1.0 / 720 + r2 * (1.0 / 40320 + r2 * (-1.0 / 3628800 + r2 * (1.0 / 479001600 + r2 * (-1.0 / 87178291200.0)))))));
    const int qi = ((int)q) & 3;
    const double ss = (qi == 0) ? s : (qi == 1) ? c : (qi == 2) ? -s : -c;
    const double cc = (qi == 0) ? c : (qi == 1) ? -s : (qi == 2) ? -c : s;
    sn = (float)ss; cs = (float)cc;
}

__device__ __forceinline__ void prologue(Frame& F, const Args& A) {
    LAS float* scr = (LAS float*)(F.lds + F.wave * 16384);
    constexpr int I_IN = 16 * 104, I_AU = 8 * 32, I_PU = 8 * 32, I_OUT = 16 * 32, I_G = 16 * 88, I_U = 16 * 88, I_DN = 44 * 32, I_PW = 4 * 2 * 4;
    constexpr int I_LAYER = I_IN + I_AU + I_PU + I_OUT + I_G + I_U + I_DN + I_PW;
    for (int it = F.gw; it < DEPTH * I_LAYER; it += F.ngw) {
        const int l = it / I_LAYER; int r = it % I_LAYER; unsigned char* wl = F.ws + WS_W + (size_t)l * W_LAYER;
        if (r < I_IN) { const int kb = r / 104, nb = r % 104; transpose_item(A.in[8] + (size_t)l * D * NIN, NIN, (bf16*)(wl + WO_IN), D, 32 * nb, 0, scr, 64 * kb, 32 * nb, F.lane); continue; } r -= I_IN;
        if (r < I_AU) { const int kb = r / 32, nb = r % 32; transpose_item(A.in[11] + (size_t)l * 512 * D, D, (bf16*)(wl + WO_UP2), D, 32 * nb, 0, scr, 64 * kb, 32 * nb, F.lane); continue; } r -= I_AU;
        if (r < I_PU) { const int kb = r / 32, nb = r % 32; transpose_item(A.in[14] + (size_t)l * 512 * D, D, (bf16*)(wl + WO_UP2), D, 32 * nb, 512, scr, 64 * kb, 32 * nb, F.lane); continue; } r -= I_PU;
        if (r < I_OUT) { const int kb = r / 32, nb = r % 32; transpose_item(A.in[15] + (size_t)l * D * D, D, (bf16*)(wl + WO_OUT), D, 32 * nb, 0, scr, 64 * kb, 32 * nb, F.lane); continue; } r -= I_OUT;
        if (r < I_G) { const int kb = r / 88, nb = r % 88, n0 = 32 * nb; transpose_item(A.in[20] + (size_t)l * D * FF, FF, (bf16*)(wl + WO_GU), D, 256 * (n0 >> 7) + (n0 & 127), 0, scr, 64 * kb, n0, F.lane); continue; } r -= I_G;
        if (r < I_U) { const int kb = r / 88, nb = r % 88, n0 = 32 * nb; transpose_item(A.in[21] + (size_t)l * D * FF, FF, (bf16*)(wl + WO_GU), D, 256 * (n0 >> 7) + 128 + (n0 & 127), 0, scr, 64 * kb, n0, F.lane); continue; } r -= I_U;
        if (r < I_DN) { const int kb = r / 32, nb = r % 32; transpose_item(A.in[22] + (size_t)l * FF * D, D, (bf16*)(wl + WO_DN), FF, 32 * nb, 0, scr, 64 * kb, 32 * nb, F.lane); continue; } r -= I_DN;
        { const int g = r / 8, kb = (r % 8) / 4, nb = r % 4; transpose_item(A.in[12] + ((size_t)l * 4 + g) * 128 * 128, 128, (bf16*)(wl + WO_PT) + (size_t)g * 128 * 128, 128, 32 * nb, 0, scr, 64 * kb, 32 * nb, F.lane); }
    }
    __syncthreads();
    for (int it = F.vcu; it < DEPTH * 48; it += F.G) mod_item(F, A, it);
    const int gt = F.vcu * 512 + F.tid, ngt = F.G * 512;
    for (int i = gt; i < 4 * DEPTH * 256 * 16; i += ngt) {
        const int c8 = i & 15, key = (i >> 4) & 255, l = (i >> 12) & 3, b = i >> 14;
        const float* src = A.in[2] + (((size_t)(b * DEPTH + l) * 256 + key) * 128 + c8 * 8);
        const f32x4 a = *(const GAS f32x4*)src, c = *(const GAS f32x4*)(src + 4);
        v4u w; w.x = cvtpk(a[0], a[1]); w.y = cvtpk(a[2], a[3]); w.z = cvtpk(c[0], c[1]); w.w = cvtpk(c[2], c[3]);
        *(GAS v4u*)((bf16*)(F.ws + WS_KL + (size_t)l * KL_LAYER) + (size_t)(b * LKEYS + key) * 128 + c8 * 8) = w;
    }
    for (int i = gt; i < 4 * DEPTH * 128 * 32; i += ngt) {
        const int p8 = i & 31, ch = (i >> 5) & 127, l = (i >> 12) & 3, b = i >> 14;
        const float* src = A.in[3] + ((size_t)(b * DEPTH + l) * 256) * 128 + ch;
        float v[8];
#pragma unroll
        for (int j = 0; j < 8; ++j) { const int p = p8 * 8 + j; const int key = (p & ~15) | swap23(p & 15); v[j] = src[(size_t)key * 128]; }
        v4u w; w.x = cvtpk(v[0], v[1]); w.y = cvtpk(v[2], v[3]); w.z = cvtpk(v[4], v[5]); w.w = cvtpk(v[6], v[7]);
        *(GAS v4u*)((bf16*)(F.ws + WS_VTL + (size_t)l * KL_LAYER) + (size_t)((b * 2) * 64 + ch) * LKEYS + p8 * 8) = w;
    }
    for (int i = gt; i < 1024 * 32; i += ngt) {
        const int s = i >> 5, k = i & 31, f = k & 15; const int pos = (k < 16) ? (s >> 6) : (s & 63);
        const float inv = __builtin_amdgcn_exp2f(-(float)f * (13.287712379549449f / 16.0f));
        float sn, cs; sincos_tab((float)pos * inv, sn, cs);
        ((float*)(F.ws + WS_ROPE))[i] = cs; ((float*)(F.ws + WS_ROPE))[1024 * 32 + i] = sn;
    }
}

__device__ __forceinline__ const float* x_in_row(const Args& A, int row) { return row < TC ? A.in[0] + (size_t)row * D : A.in[1] + (size_t)(row - TC) * D; }

__device__ __forceinline__ void norm_mod_store(Frame& F, const f32x4 (&x)[4], const float* gain, const float* sc, const float* sh, bf16* orow) {
    float s = 0.f;
#pragma unroll
    for (int j = 0; j < 4; ++j) s += (x[j][0] * x[j][0] + x[j][1] * x[j][1]) + (x[j][2] * x[j][2] + x[j][3] * x[j][3]);
    const float rstd = 1.0f / sqrtf(wave_sum(s) * (1.0f / D) + EPS);
#pragma unroll
    for (int j = 0; j < 4; ++j) { const int c = 4 * F.lane + 256 * j;
        const f32x4 g = *(const GAS f32x4*)(gain + c), a = *(const GAS f32x4*)(sc + c), b = *(const GAS f32x4*)(sh + c);
        const f32x4 h = x[j] * rstd * g * (a + 1.0f) + b;
        v2u w; w.x = cvtpk(h[0], h[1]); w.y = cvtpk(h[2], h[3]); *(GAS v2u*)(orow + c) = w; }
}

__device__ __forceinline__ void rowpass_first(Frame& F, const Args& A) {
    const float* mod = (const float*)(F.ws + WS_MOD);
    for (int row = F.gw; row < T; row += F.ngw) { const float* xr = x_in_row(A, row); f32x4 x[4];
#pragma unroll
        for (int j = 0; j < 4; ++j) x[j] = *(const GAS f32x4*)(xr + 4 * F.lane + 256 * j);
        const float* m = mod + (size_t)mod_index(row) * NMOD;
        norm_mod_store(F, x, A.in[16], m + 1 * D, m + 0 * D, (bf16*)(F.ws + WS_HA) + (size_t)row * D); }
}

__device__ __forceinline__ void rowpass(Frame& F, const Args& A, bool dry, bool x_from_input, const float* post_gain, const float* modl, int gate_off, const float* next_gain, const float* next_modl, int next_sc_off, int next_sh_off) {
    const float* Y = (const float*)(F.ws + WS_MO); float* X = F.out + OUT_Y;
    float* XO = dry ? (float*)(F.ws + WS_AP) : X; bf16* HO = dry ? (bf16*)(F.ws + WS_G) : (bf16*)(F.ws + WS_HA);
    for (int row = F.gw; row < T; row += F.ngw) {
        const float* xr = x_from_input ? x_in_row(A, row) : X + (size_t)row * D; const float* yr = Y + (size_t)row * D; const int mi = mod_index(row);
        f32x4 x[4], y[4]; float s = 0.f;
#pragma unroll
        for (int j = 0; j < 4; ++j) { x[j] = *(const GAS f32x4*)(xr + 4 * F.lane + 256 * j); y[j] = *(const GAS f32x4*)(yr + 4 * F.lane + 256 * j);
            s += (y[j][0] * y[j][0] + y[j][1] * y[j][1]) + (y[j][2] * y[j][2] + y[j][3] * y[j][3]); }
        const float rstd = 1.0f / sqrtf(wave_sum(s) * (1.0f / D) + EPS);
        const float* gate = modl + (size_t)mi * NMOD + gate_off;
#pragma unroll
        for (int j = 0; j < 4; ++j) { const int c = 4 * F.lane + 256 * j; const f32x4 g = *(const GAS f32x4*)(gate + c), pg = *(const GAS f32x4*)(post_gain + c);
            x[j] = x[j] + g * (y[j] * rstd * pg); *(GAS f32x4*)(XO + (size_t)row * D + c) = x[j]; }
        if (next_gain) { const float* m = next_modl + (size_t)mi * NMOD; norm_mod_store(F, x, next_gain, m + next_sc_off, m + next_sh_off, HO + (size_t)row * D); }
    }
}

constexpr int AT_SLOT = 16384;
__device__ __forceinline__ void attn_wg_unit(LAS unsigned char* lds, const bf16* Qb, const bf16* Kb, const bf16* VTb, int vld, int nt, bf16* Ob, int wave, int lane) {
    const int r = lane & 31, hh = lane >> 5, hq = wave >> 1, rh = wave & 1;
    const int drow = 8 * wave + (lane >> 3), dp = (lane & 7) ^ ((drow >> 1) & 7);
    const bf16* ksrc = Kb + (size_t)drow * 128 + dp * 8; const bf16* vsrc = VTb + (size_t)drow * vld + dp * 8;
    const unsigned kdst = (unsigned)wave * 1024u, vdst = 8192u + (unsigned)wave * 1024u;
#define AT_DMA(t) do { const unsigned sl_ = (unsigned)((t) & 3) * AT_SLOT; \
        __builtin_amdgcn_global_load_lds((const unsigned*)(ksrc + (size_t)(t) * 64 * 128), (LAS unsigned*)(lds + sl_ + kdst), 16, 0, 0); \
        __builtin_amdgcn_global_load_lds((const unsigned*)(vsrc + (size_t)(t) * 64), (LAS unsigned*)(lds + sl_ + vdst), 16, 0, 0); } while (0)
    asm volatile("s_waitcnt lgkmcnt(0)" ::: "memory"); __builtin_amdgcn_s_barrier();
    const bf16* Qw = Qb + (size_t)(rh * 32 + r) * 512 + hq * 64 + 8 * hh;
    bf16x8 qf[4];
#pragma unroll
    for (int ks = 0; ks < 4; ++ks) qf[ks] = *(const GAS bf16x8*)(Qw + 16 * ks);
    AT_DMA(0); if (nt > 1) AT_DMA(1); if (nt > 2) AT_DMA(2);
    asm volatile("" : "+v"(qf[0]), "+v"(qf[1]), "+v"(qf[2]), "+v"(qf[3]));
    const int swz = (r >> 1) & 7, rowoff = r * 128;
    f32x16 o0, o1;
#pragma unroll
    for (int i = 0; i < 16; ++i) { o0[i] = 0.f; o1[i] = 0.f; }
    float mrun = -1e30f, lrun = 0.f;
#pragma unroll 1
    for (int t = 0; t < nt; ++t) {
        const int ahead = nt - 1 - t;
        if (ahead >= 2) asm volatile("s_waitcnt vmcnt(4) lgkmcnt(0)" ::: "memory"); else if (ahead == 1) asm volatile("s_waitcnt vmcnt(2) lgkmcnt(0)" ::: "memory"); else asm volatile("s_waitcnt vmcnt(0) lgkmcnt(0)" ::: "memory");
        __builtin_amdgcn_s_barrier();
        if (t + 3 < nt) AT_DMA(t + 3);
        const LAS unsigned char* kimg = lds + (unsigned)(t & 3) * AT_SLOT; const LAS unsigned char* vimg = kimg + 8192;
        f32x16 s0, s1;
#pragma unroll
        for (int i = 0; i < 16; ++i) { s0[i] = 0.f; s1[i] = 0.f; }
#pragma unroll
        for (int ks = 0; ks < 4; ++ks) { const int off = rowoff + (((2 * ks + hh) ^ swz) << 4);
            const bf16x8 k0 = *(const LAS bf16x8*)(kimg + off), k1 = *(const LAS bf16x8*)(kimg + 4096 + off);
            s0 = __builtin_amdgcn_mfma_f32_32x32x16_bf16(k0, qf[ks], s0, 0, 0, 0); s1 = __builtin_amdgcn_mfma_f32_32x32x16_bf16(k1, qf[ks], s1, 0, 0, 0); }
        float mx = fmaxf(s0[0], s1[0]);
#pragma unroll
        for (int i = 1; i < 16; ++i) mx = fmaxf(mx, fmaxf(s0[i], s1[i]));
        mx = fmaxf(mx, __shfl_xor(mx, 32));
        const float mnew = fmaxf(mrun, mx), alpha = __builtin_amdgcn_exp2f(mrun - mnew);
        float rsum = 0.f;
#pragma unroll
        for (int i = 0; i < 16; ++i) { s0[i] = __builtin_amdgcn_exp2f(s0[i] - mnew); s1[i] = __builtin_amdgcn_exp2f(s1[i] - mnew); rsum += s0[i] + s1[i]; }
        lrun = lrun * alpha + rsum; mrun = mnew;
#pragma unroll
        for (int i = 0; i < 16; ++i) { o0[i] *= alpha; o1[i] *= alpha; }
        v4u p[4];
        p[0].x = cvtpk(s0[0], s0[1]); p[0].y = cvtpk(s0[2], s0[3]); p[0].z = cvtpk(s0[4], s0[5]); p[0].w = cvtpk(s0[6], s0[7]);
        p[1].x = cvtpk(s0[8], s0[9]); p[1].y = cvtpk(s0[10], s0[11]); p[1].z = cvtpk(s0[12], s0[13]); p[1].w = cvtpk(s0[14], s0[15]);
        p[2].x = cvtpk(s1[0], s1[1]); p[2].y = cvtpk(s1[2], s1[3]); p[2].z = cvtpk(s1[4], s1[5]); p[2].w = cvtpk(s1[6], s1[7]);
        p[3].x = cvtpk(s1[8], s1[9]); p[3].y = cvtpk(s1[10], s1[11]); p[3].z = cvtpk(s1[12], s1[13]); p[3].w = cvtpk(s1[14], s1[15]);
#pragma unroll
        for (int s = 0; s < 4; ++s) { const int off = rowoff + (((2 * s + hh) ^ swz) << 4); const bf16x8 pb = __builtin_bit_cast(bf16x8, p[s]);
            const bf16x8 v0 = *(const LAS bf16x8*)(vimg + off), v1 = *(const LAS bf16x8*)(vimg + 4096 + off);
            o0 = __builtin_amdgcn_mfma_f32_32x32x16_bf16(v0, pb, o0, 0, 0, 0); o1 = __builtin_amdgcn_mfma_f32_32x32x16_bf16(v1, pb, o1, 0, 0, 0); }
    }
#undef AT_DMA
    lrun += __shfl_xor(lrun, 32);
    const float inv = 1.0f / lrun;
    bf16* op = Ob + (size_t)(rh * 32 + r) * D + hq * 64 + 4 * hh;
#pragma unroll
    for (int g4 = 0; g4 < 4; ++g4) {
        v2u w; w.x = cvtpk(o0[4 * g4] * inv, o0[4 * g4 + 1] * inv); w.y = cvtpk(o0[4 * g4 + 2] * inv, o0[4 * g4 + 3] * inv); *(GAS v2u*)(op + 8 * g4) = w;
        v2u z; z.x = cvtpk(o1[4 * g4] * inv, o1[4 * g4 + 1] * inv); z.y = cvtpk(o1[4 * g4 + 2] * inv, o1[4 * g4 + 3] * inv); *(GAS v2u*)(op + 32 + 8 * g4) = z; }
}

constexpr int PL_PITCH = 1040, PL_ROWS = 47, PL_DOFF = 49152;
template <int G>
__device__ __forceinline__ void pool_slide(const LAS unsigned char* in, LAS unsigned char* dimg, int c, int s0, int n) {
    constexpr int W = 2 << G, LEFT = W / 2, RIGHT = W / 2 - 1, R0 = 8 - LEFT, R1 = 39 + RIGHT;
    float v[PL_ROWS];
#pragma unroll
    for (int i = R0; i <= R1; ++i) { const int pos = s0 - 8 + i; const float x = __uint_as_float((unsigned)(*(const LAS unsigned short*)(in + i * PL_PITCH + c * 2)) << 16); v[i] = (pos >= 0 && pos < n) ? x : 0.f; }
    float sum = 0.f;
#pragma unroll
    for (int i = 8 - LEFT; i <= 8 + RIGHT; ++i) sum += v[i];
#pragma unroll
    for (int j = 0; j < 32; ++j) { const int pos = s0 + j; const int lo = max(pos - LEFT, 0), hi = min(pos + RIGHT + 1, n);
        const float d = sum * __builtin_amdgcn_rcpf((float)(hi - lo)) - v[j + 8];
        *(LAS unsigned short*)(dimg + j * PL_PITCH + c * 2) = (unsigned short)(cvtpk(d, d) & 0xffffu);
        if (j < 31) sum += v[j + 9 + RIGHT] - v[j + 8 - LEFT]; }
}
__device__ __forceinline__ void pool_wg_unit(LAS unsigned char* lds, const bf16* P, const bf16* WpT, const float* pscale, bf16* AP, int tb, int tid, int wave, int lane) {
    const int r = lane & 31, hh = lane >> 5, g = wave & 3, kh = wave >> 2; const int row0 = tb * 32;
    int n, seq0; if (row0 < TC) { n = 256; seq0 = row0 & ~255; } else { n = 1024; seq0 = TC + ((row0 - TC) & ~1023); }
    v4u st[6];
#pragma unroll
    for (int i = 0; i < 6; ++i) { const int idx = tid + 512 * i; const int ir = min(idx >> 6, PL_ROWS - 1); int srow = row0 - 8 + ir; srow = max(seq0, min(srow, seq0 + n - 1));
        st[i] = *(const GAS v4u*)(P + (size_t)srow * 512 + (idx & 63) * 8); }
    bf16x8 wf[2][8];
#pragma unroll
    for (int j = 0; j < 2; ++j)
#pragma unroll
        for (int ks = 0; ks < 8; ++ks) wf[j][ks] = *(const GAS bf16x8*)(WpT + (size_t)(g * 128 + 32 * (2 * kh + j) + r) * 128 + 16 * ks + 8 * hh);
    asm volatile("s_waitcnt lgkmcnt(0)" ::: "memory"); __builtin_amdgcn_s_barrier();
#pragma unroll
    for (int i = 0; i < 6; ++i) { const int idx = tid + 512 * i; if (idx < PL_ROWS * 64) *(LAS v4u*)(lds + (idx >> 6) * PL_PITCH + (idx & 63) * 16) = st[i]; }
    __syncthreads();
    { const int gs = wave >> 1, s0 = row0 - seq0;
      if (gs == 0) pool_slide<0>(lds, lds + PL_DOFF, tid, s0, n); else if (gs == 1) pool_slide<1>(lds, lds + PL_DOFF, tid, s0, n);
      else if (gs == 2) pool_slide<2>(lds, lds + PL_DOFF, tid, s0, n); else pool_slide<3>(lds, lds + PL_DOFF, tid, s0, n); }
    __syncthreads();
    const int t = row0 + r;
    const LAS unsigned char* dbase = lds + PL_DOFF + r * PL_PITCH + (g * 128 + 8 * hh) * 2;
    bf16x8 df[8];
#pragma unroll
    for (int ks = 0; ks < 8; ++ks) df[ks] = *(const LAS bf16x8*)(dbase + 32 * ks);
    bf16* orow = AP + (size_t)t * D + 512 + g * 128 + 4 * hh;
#pragma unroll
    for (int j = 0; j < 2; ++j) { const int nt = 2 * kh + j; f32x16 c;
#pragma unroll
        for (int i = 0; i < 16; ++i) c[i] = 0.f;
#pragma unroll
        for (int ks = 0; ks < 8; ++ks) c = __builtin_amdgcn_mfma_f32_32x32x16_bf16(wf[j][ks], df[ks], c, 0, 0, 0);
#pragma unroll
        for (int g4 = 0; g4 < 4; ++g4) { const f32x4 sc = *(const GAS f32x4*)(pscale + g * 128 + 32 * nt + 8 * g4 + 4 * hh);
            v2u w; w.x = cvtpk(c[4 * g4] * sc[0], c[4 * g4 + 1] * sc[1]); w.y = cvtpk(c[4 * g4 + 2] * sc[2], c[4 * g4 + 3] * sc[3]); *(GAS v2u*)(orow + 32 * nt + 8 * g4) = w; } }
}

#ifndef DUPMASK
#define DUPMASK 0
#endif
#define REPS(bit) (((DUPMASK) & (bit)) ? 2 : 1)
__device__ __forceinline__ void mix_phase(Frame& F, const Args& A, int l) {
    const bf16* Q = (const bf16*)(F.ws + WS_Q); bf16* AP = (bf16*)(F.ws + WS_AP);
    const int c = F.vcu, w = F.wave;
    if (c < 128) {
#pragma unroll 1
        for (int rep = 0; rep < REPS(2048); ++rep) {
        const int b = c >> 5, kvh = (c >> 4) & 1, qblk = c & 15; const int q0 = TC + b * 1024 + qblk * 64;
        attn_wg_unit(F.lds, Q + (size_t)q0 * 512 + kvh * 256, (const bf16*)(F.ws + WS_KL + (size_t)l * KL_LAYER) + (size_t)(b * LKEYS) * 128 + kvh * 64,
                     (const bf16*)(F.ws + WS_VTL + (size_t)l * KL_LAYER) + (size_t)((b * 2 + kvh) * 64) * LKEYS, LKEYS, LKEYS / 64, AP + (size_t)q0 * D + kvh * 256, w, F.lane); }
    } else {
        const int cc = c - 128;
#pragma unroll 1
        for (int i = 0; i < 2 * REPS(2048); ++i) { const int u = 2 * cc + (i & 1), b = u >> 3, kvh = (u >> 2) & 1, qblk = u & 3; const int q0 = b * 256 + qblk * 64;
            attn_wg_unit(F.lds, Q + (size_t)q0 * 512 + kvh * 256, (const bf16*)(F.ws + WS_KC) + (size_t)(b * 256) * 128 + kvh * 64,
                         (const bf16*)(F.ws + WS_VTC) + (size_t)((b * 2 + kvh) * 64) * 256, 256, 4, AP + (size_t)q0 * D + kvh * 256, w, F.lane); }
        const bf16* P = (const bf16*)(F.ws + WS_P); const bf16* WpT = (const bf16*)(F.ws + WS_W + (size_t)l * W_LAYER + WO_PT); const float* ps = A.in[13] + (size_t)l * 512;
#pragma unroll 1
        for (int rep = 0; rep < REPS(4096); ++rep)
#pragma unroll 1
        for (int tb = cc; tb < 384; tb += 128) pool_wg_unit(F.lds, P, WpT, ps, AP, tb, F.tid, w, F.lane);
    }
}

__global__ void __launch_bounds__(NWAVES * 64, 2) fwd_kernel(Args A) {
    extern __shared__ __attribute__((aligned(16))) unsigned char lds_raw[];
    Frame F;
    F.lds = (LAS unsigned char*)lds_raw;
    F.tid = threadIdx.x; F.lane = F.tid & 63; F.wave = __builtin_amdgcn_readfirstlane(F.tid >> 6);
    F.G = gridDim.x; { const int bx = blockIdx.x; F.vcu = (F.G % 8 == 0) ? (bx % 8) * (F.G / 8) + bx / 8 : bx; }
    F.gw = F.vcu * NWAVES + F.wave; F.ngw = F.G * NWAVES;
    F.out = A.out; F.ws = A.ws;
    for (int u = F.tid; u < (LDS_BYTES - LDSCTL_OFF) / 4; u += NWAVES * 64) ((LAS unsigned*)(F.lds + LDSCTL_OFF))[u] = 0u;
    __syncthreads();
    XcdBarrier bar = xcd_barrier_post((unsigned*)(F.ws + WS_CTL) + CW_BAR, (volatile LAS unsigned*)(F.lds + MISC_OFF) + 8);
#define GRID_BAR() do { xcd_barrier(bar); int t_ = threadIdx.x; asm volatile("" : "+v"(t_)); F.tid = t_; F.lane = t_ & 63; } while (0)

#pragma unroll 1
    for (int rep = 0; rep < REPS(1); ++rep) prologue(F, A);
    GRID_BAR();
#pragma unroll 1
    for (int rep = 0; rep < REPS(2); ++rep) rowpass_first(F, A);
    GRID_BAR();

    const float* MOD = (const float*)(F.ws + WS_MOD);
#pragma unroll 1
    for (int l = 0; l < DEPTH; ++l) {
        unsigned char* wl = F.ws + WS_W + (size_t)l * W_LAYER; const float* modl = MOD + (size_t)l * 5 * NMOD;
#pragma unroll 1
        for (int rep = 0; rep < REPS(4); ++rep) {
            pg8::Gemm g{(const bf16*)(F.ws + WS_HA), (const bf16*)(wl + WO_IN), T, NIN, D}; pg8::StaticOrder S; S.init(T, NIN, F.G, (int)blockIdx.x);
            EpiIn E{(bf16*)(F.ws + WS_Q), (bf16*)(F.ws + WS_KC), (bf16*)(F.ws + WS_VTC), (bf16*)(F.ws + WS_KL + (size_t)l * KL_LAYER), (bf16*)(F.ws + WS_VTL + (size_t)l * KL_LAYER),
                    (bf16*)(F.ws + WS_P), (bf16*)(F.ws + WS_G), F.out + OUT_NK, F.out + OUT_NV, A.in[9] + l * 64, A.in[10] + l * 64,
                    (const float*)(F.ws + WS_ROPE), (const float*)(F.ws + WS_ROPE) + 1024 * 32, l};
            pg8::gemm_phase<EpiIn, pg8::StaticOrder, true, true>(F.lds, g, S, E);
        }
        GRID_BAR();
#pragma unroll 1
        for (int rep = 0; rep < REPS(8); ++rep) mix_phase(F, A, l);
        GRID_BAR();
#pragma unroll 1
        for (int rep = 0; rep < REPS(16); ++rep) {
            pg8::Gemm g{(const bf16*)(F.ws + WS_AP), (const bf16*)(wl + WO_UP2), T, D, D}; pg8::StaticOrder S; S.init(T, D, F.G, (int)blockIdx.x);
            EpiUp E{(const bf16*)(F.ws + WS_G), (bf16*)(F.ws + WS_MIX)};
            pg8::gemm_phase<EpiUp, pg8::StaticOrder, true, true>(F.lds, g, S, E);
        }
        GRID_BAR();
#pragma unroll 1
        for (int rep = 0; rep < REPS(32); ++rep) {
            pg8::Gemm g{(const bf16*)(F.ws + WS_MIX), (const bf16*)(wl + WO_OUT), T, D, D}; pg8::StaticOrder S; S.init(T, D, F.G, (int)blockIdx.x);
            EpiF32 E{(float*)(F.ws + WS_MO)};
            pg8::gemm_phase<EpiF32, pg8::StaticOrder, true, true>(F.lds, g, S, E);
        }
        GRID_BAR();
#pragma unroll 1
        for (int rep = 0; rep < REPS(64); ++rep)
            rowpass(F, A, rep + 1 < REPS(64), l == 0, A.in[17] + (size_t)l * D, modl, 2 * D, A.in[18] + (size_t)l * D, modl, 4 * D, 3 * D);
        GRID_BAR();
#pragma unroll 1
        for (int rep = 0; rep < REPS(128); ++rep) {
            pg8::Gemm g{(const bf16*)(F.ws + WS_HA), (const bf16*)(wl + WO_GU), T, 2 * FF, D}; pg8::StaticOrder S; S.init(T, 2 * FF, F.G, (int)blockIdx.x);
            EpiGU E{(bf16*)(F.ws + WS_HID)};
            pg8::gemm_phase<EpiGU, pg8::StaticOrder, true, true>(F.lds, g, S, E);
        }
        GRID_BAR();
#pragma unroll 1
        for (int rep = 0; rep < REPS(256); ++rep) {
            pg8::Gemm g{(const bf16*)(F.ws + WS_HID), (const bf16*)(wl + WO_DN), T, D, FF}; pg8::StaticOrder S; S.init(T, D, F.G, (int)blockIdx.x);
            EpiF32 E{(float*)(F.ws + WS_MO)};
            pg8::gemm_phase<EpiF32, pg8::StaticOrder, true, true>(F.lds, g, S, E);
        }
        GRID_BAR();
#pragma unroll 1
        for (int rep = 0; rep < REPS(512); ++rep) {
            const bool dry = rep + 1 < REPS(512);
            if (l + 1 < DEPTH) rowpass(F, A, dry, false, A.in[19] + (size_t)l * D, modl, 5 * D, A.in[16] + (size_t)(l + 1) * D, modl + 5 * NMOD, 1 * D, 0);
            else rowpass(F, A, dry, false, A.in[19] + (size_t)l * D, modl, 5 * D, nullptr, modl, 0, 0);
        }
        if (l + 1 < DEPTH) GRID_BAR();
#pragma unroll 1
        for (int rep = 0; rep < ((DUPMASK & 1024) ? 8 : 0); ++rep) GRID_BAR();
    }
}

extern "C" void kernel_launch(void* const* d_in, const int* in_sizes, int n_in, void* d_out, int out_size, void* d_ws, size_t ws_size, hipStream_t stream) {
    static int grid = 0;
    if (grid == 0) {
        if (n_in != 23 || out_size != (int)(OUT_NV + (size_t)32 * 4 * 256 * 128) || ws_size < WS_END) {
            fprintf(stderr, "kernel_launch: unexpected shapes (n_in %d, out %d, ws %zu); nothing launched\n", n_in, out_size, ws_size); grid = -1; return; }
        int dev = 0, cus = 0, per_cu = 0;
        if (hipGetDevice(&dev) != hipSuccess || hipDeviceGetAttribute(&cus, hipDeviceAttributeMultiprocessorCount, dev) != hipSuccess) { grid = -1; return; }
        if (hipFuncSetAttribute((const void*)fwd_kernel, hipFuncAttributeMaxDynamicSharedMemorySize, LDS_BYTES) != hipSuccess) { fprintf(stderr, "kernel_launch: hipFuncSetAttribute failed\n"); grid = -1; return; }
        if (hipOccupancyMaxActiveBlocksPerMultiprocessor(&per_cu, (const void*)fwd_kernel, NWAVES * 64, LDS_BYTES) != hipSuccess || per_cu < 1) { fprintf(stderr, "kernel_launch: note: occupancy query says %d blocks per CU; launching one per CU anyway\n", per_cu); (void)hipGetLastError(); }
        grid = cus;
    }
    if (grid < 0) return;
    (void)hipMemsetAsync((char*)d_ws + WS_CTL, 0, CTL_ZERO_BYTES, stream);
    Args a{};
    for (int i = 0; i < 23; ++i) a.in[i] = (const float*)d_in[i];
    a.out = (float*)d_out; a.ws = (unsigned char*)d_ws;
    void* kargs[] = {&a};
    hipError_t e = hipLaunchCooperativeKernel((const void*)fwd_kernel, dim3(grid), dim3(NWAVES * 64), kargs, LDS_BYTES, stream);
    if (e != hipSuccess) fprintf(stderr, "kernel_launch: cooperative launch failed: %s (grid %d)\n", hipGetErrorString(e), grid);
}
```
